# Optimizing an MI355X kernel written in HIP

```python
import math
import jax, jax.numpy as jnp
from jax import lax
import numpy as np

D_MODEL = 2048
BATCH = 1
SEQ = 8192
DEPTH = 4

GRID_W = 64
Q_BLOCK = 128
HEAD_DIM = 128
N_BRANCH = 4
BRANCH_W = D_MODEL // 4
DA_QK = HEAD_DIM // 2
DA_V = HEAD_DIM
HA = BRANCH_W // DA_V
HB = BRANCH_W // HEAD_DIM
NB_ROWS_MAX = 8
NB_COLS = 16
HC = BRANCH_W // HEAD_DIM
KVC = HC // 2
AXIAL_THETA = 10000.0
DIL_WINDOWS = (128, 512, 2048)
DIL_RATES = (1, 4, 16)
N_DIL = 3
HD_PER = BRANCH_W // HEAD_DIM
HD = N_DIL * HD_PER
DIL_SIDE = 64
ROPE_THETA = 500000.0
ROPE_FRAC = 4
DN_ALPHA = (2 * DEPTH) ** 0.25
DN_BETA = (8 * DEPTH) ** -0.25
LN_EPS = 1e-5
RMS_EPS = 1e-6
NEG_INF = -1e30

IN_SIZES = (
    HA * 2 * DA_QK, HA * 2 * DA_QK, HA * DA_V, BRANCH_W,
    HB * HEAD_DIM, HB * HEAD_DIM, HB * HEAD_DIM, BRANCH_W,
    HC * HEAD_DIM, KVC * HEAD_DIM, KVC * HEAD_DIM, BRANCH_W,
    HD * HEAD_DIM, HD * HEAD_DIM, HD * HEAD_DIM, BRANCH_W,
    N_BRANCH * D_MODEL,
)
D_IN = sum(IN_SIZES)

kernel_name = 'hybrid_gated_multi_mixer_encoder'


def _split(h, sizes):
    outs, start = [], 0
    for n in sizes:
        outs.append(h[..., start:start + n])
        start += n
    return outs


def _layer_norm(x, g, b):
    xf = x.astype(jnp.float32)
    mu = jnp.mean(xf, -1, keepdims=True)
    var = jnp.mean(jnp.square(xf - mu), -1, keepdims=True)
    y = (xf - mu) * lax.rsqrt(var + LN_EPS)
    return (y * g.astype(jnp.float32) + b.astype(jnp.float32)).astype(x.dtype)


def _rms_norm(x, g):
    xf = x.astype(jnp.float32)
    y = xf * lax.rsqrt(jnp.mean(xf * xf, -1, keepdims=True) + RMS_EPS)
    return (y * g.astype(jnp.float32)).astype(x.dtype)


def _rope(x, pos, theta):
    dim = x.shape[-1]
    half = dim // 2
    inv = jnp.power(jnp.float32(theta), -jnp.arange(half, dtype=jnp.float32) * 2.0 / dim)
    ang = pos.astype(jnp.float32)[:, None] * inv[None, :]
    cos = jnp.cos(ang)[None, :, None, :].astype(x.dtype)
    sin = jnp.sin(ang)[None, :, None, :].astype(x.dtype)
    x1, x2 = x[..., :half], x[..., half:]
    return jnp.concatenate([x1 * cos - x2 * sin, x2 * cos + x1 * sin], -1)


def _partial_rope(x, pos):
    r = x.shape[-1] // ROPE_FRAC
    return jnp.concatenate([_rope(x[..., :r], pos, ROPE_THETA), x[..., r:]], -1)


def _to_blocks(t):
    b, s = t.shape[:2]
    t = t.reshape((b, s // Q_BLOCK, Q_BLOCK) + t.shape[2:])
    return jnp.moveaxis(t, 1, 0)


def _from_blocks(t):
    t = jnp.moveaxis(t, 0, 1)
    return t.reshape((t.shape[0], t.shape[1] * t.shape[2]) + t.shape[3:])


def _diff_attention(q, k, v, lam_params, subln_g, lam_init, pos):
    b, s = q.shape[:2]
    q = _partial_rope(q.reshape(b, s, HA * 2, DA_QK), pos).reshape(b, s, HA, 2, DA_QK) * (DA_QK ** -0.5)
    k = _partial_rope(k.reshape(b, s, HA * 2, DA_QK), pos).reshape(b, s, HA, 2, DA_QK)
    lp = lam_params.astype(jnp.float32)
    lam = jnp.exp(jnp.sum(lp[0] * lp[1])) - jnp.exp(jnp.sum(lp[2] * lp[3])) + lam_init

    def block(qb):
        sc = jnp.einsum('bqhcd,bshcd->bhcqs', qb, k).astype(jnp.float32)
        p = jax.nn.softmax(sc, axis=-1)
        a = p[:, :, 0] - lam * p[:, :, 1]
        return jnp.einsum('bhqs,bshd->bqhd', a.astype(v.dtype), v)

    o = _from_blocks(lax.map(block, _to_blocks(q)))
    o = _rms_norm(o, subln_g) * (1.0 - lam_init)
    return o.reshape(b, s, HA * DA_V)


def _neighbourhood_attention(q, k, v, rpb):
    b, s = q.shape[:2]
    rows = s // GRID_W
    kr = min(NB_ROWS_MAX, rows)
    kc = NB_COLS
    qg = jnp.moveaxis((q * HEAD_DIM ** -0.5).reshape(b, rows, GRID_W, HB, HEAD_DIM), 1, 0)
    kg = k.reshape(b, rows, GRID_W, HB, HEAD_DIM)
    vg = v.reshape(b, rows, GRID_W, HB, HEAD_DIM)
    cols = jnp.arange(GRID_W)
    col_idx = jnp.clip(cols - kc // 2, 0, GRID_W - kc)[:, None] + jnp.arange(kc)[None, :]
    dc = col_idx - cols[:, None] + (NB_COLS - 1)

    def row_block(args):
        r, qr = args
        r0 = jnp.clip(r - kr // 2, 0, rows - kr)
        k_nb = lax.dynamic_slice_in_dim(kg, r0, kr, axis=1)[:, :, col_idx]
        v_nb = lax.dynamic_slice_in_dim(vg, r0, kr, axis=1)[:, :, col_idx]
        dr = r0 + jnp.arange(kr) - r + (NB_ROWS_MAX - 1)
        bias = rpb[:, dr[None, :, None], dc[:, None, :]]
        sc = jnp.einsum('bchd,brcjhd->bhcrj', qr, k_nb).astype(jnp.float32) + bias.astype(jnp.float32)[None]
        p = jax.nn.softmax(sc.reshape(b, HB, GRID_W, kr * kc), axis=-1).reshape(sc.shape)
        return jnp.einsum('bhcrj,brcjhd->bchd', p.astype(v.dtype), v_nb)

    o = lax.map(row_block, (jnp.arange(rows), qg))
    return jnp.moveaxis(o, 0, 1).reshape(b, s, HB * HEAD_DIM)


def _axial_gqa(q, k, v, qn_g, kn_g):
    b, s = q.shape[:2]
    t = jnp.arange(s)
    row, col = t // GRID_W, t % GRID_W
    half = HEAD_DIM // 2

    def axial(z):
        return jnp.concatenate([_rope(z[..., :half], row, AXIAL_THETA), _rope(z[..., half:], col, AXIAL_THETA)], -1)

    q = (axial(_rms_norm(q, qn_g)) * HEAD_DIM ** -0.5).reshape(b, s, KVC, HC // KVC, HEAD_DIM)
    k = axial(_rms_norm(k, kn_g))

    def block(qb):
        sc = jnp.einsum('bqkgd,bskd->bkgqs', qb, k).astype(jnp.float32)
        p = jax.nn.softmax(sc, axis=-1)
        return jnp.einsum('bkgqs,bskd->bqkgd', p.astype(v.dtype), v)

    o = _from_blocks(lax.map(block, _to_blocks(q)))
    return o.reshape(b, s, HC * HEAD_DIM)


def _dilated_attention(q, k, v, pos):
    b, s = q.shape[:2]
    shp = (b, s, N_DIL, HD_PER, HEAD_DIM)
    q = (_partial_rope(q, pos) * HEAD_DIM ** -0.5).reshape(shp)
    k = _partial_rope(k, pos).reshape(shp)
    v = v.reshape(shp)
    offsets = jnp.array(DIL_RATES, dtype=jnp.int32)[:, None] * jnp.arange(-DIL_SIDE, DIL_SIDE + 1, dtype=jnp.int32)[None, :]
    g_idx = jnp.arange(N_DIL)[None, :, None]

    def block(args):
        i, qb = args
        t = i * Q_BLOCK + jnp.arange(Q_BLOCK, dtype=jnp.int32)
        idx = t[:, None, None] + offsets[None]
        valid = (idx >= 0) & (idx < s)
        idx = jnp.clip(idx, 0, s - 1)
        k_nb = k[:, idx, g_idx]
        v_nb = v[:, idx, g_idx]
        sc = jnp.einsum('bqghd,bqgjhd->bghqj', qb, k_nb).astype(jnp.float32)
        sc = jnp.where(jnp.moveaxis(valid, 0, 1)[None, :, None], sc, NEG_INF)
        m = jnp.max(sc, -1, keepdims=True)
        e = jnp.exp(sc - m)
        den = jnp.sum(e, -1, keepdims=True)
        o = jnp.einsum('bghqj,bqgjhd->bqghd', (e / den).astype(v.dtype), v_nb)
        lse = (m + jnp.log(den))[..., 0]
        w = jnp.transpose(jax.nn.softmax(lse, axis=1), (0, 3, 1, 2))[..., None]
        return jnp.sum(o * w.astype(o.dtype), axis=2)

    o = _from_blocks(lax.map(block, (jnp.arange(s // Q_BLOCK, dtype=jnp.int32), _to_blocks(q))))
    return o.reshape(b, s, HD_PER * HEAD_DIM)


def _hybrid_layer(x, w_in, b_gate, lam_params, subln_g, rpb, qn_g, kn_g, w_branch, w_out, ln_g, ln_b, lam_init):
    b, s, _ = x.shape
    pos = jnp.arange(s, dtype=jnp.int32)
    h = jnp.einsum('bsd,de->bse', x, w_in)
    (aq, ak, av, az, bq, bk, bv, bz, cq, ck, cv, cz, dq, dk, dv, dz, gl) = _split(h, IN_SIZES)
    ya = _diff_attention(aq.reshape(b, s, HA, 2, DA_QK), ak.reshape(b, s, HA, 2, DA_QK),
                         av.reshape(b, s, HA, DA_V), lam_params, subln_g, lam_init, pos)
    yb = _neighbourhood_attention(bq.reshape(b, s, HB, HEAD_DIM), bk.reshape(b, s, HB, HEAD_DIM),
                                  bv.reshape(b, s, HB, HEAD_DIM), rpb)
    yc = _axial_gqa(cq.reshape(b, s, HC, HEAD_DIM), ck.reshape(b, s, KVC, HEAD_DIM),
                    cv.reshape(b, s, KVC, HEAD_DIM), qn_g, kn_g)
    yd = _dilated_attention(dq.reshape(b, s, HD, HEAD_DIM), dk.reshape(b, s, HD, HEAD_DIM),
                            dv.reshape(b, s, HD, HEAD_DIM), pos)
    ys = jnp.stack([ya * jax.nn.silu(az), yb * jax.nn.silu(bz),
                    yc * jax.nn.silu(cz), yd * jax.nn.silu(dz)], axis=2)
    proj = jnp.einsum('bsnw,nwd->bsnd', ys, w_branch)
    gates = jax.nn.sigmoid((gl + b_gate).astype(jnp.float32)).astype(x.dtype).reshape(b, s, N_BRANCH, D_MODEL)
    merged = jnp.sum(proj * gates, axis=2)
    out = jnp.einsum('bsd,de->bse', merged, w_out)
    return _layer_norm(DN_ALPHA * x + out, ln_g, ln_b)


def setup_inputs(seed: int = 0) -> dict:
    key = jax.random.key(seed)
    ks = jax.random.split(key, 16)
    L, D = DEPTH, D_MODEL
    nrm = jax.random.normal
    return {
        'x': nrm(ks[0], (BATCH, SEQ, D), jnp.float32),
        'emb_ln_g': 1.0 + 0.01 * nrm(ks[1], (D,), jnp.float32),
        'emb_ln_b': 0.01 * nrm(ks[2], (D,), jnp.float32),
        'w_in': nrm(ks[3], (L, D, D_IN), jnp.float32) * D ** -0.5,
        'b_gate': 0.01 * nrm(ks[4], (L, N_BRANCH * D), jnp.float32),
        'diff_lambda': 0.1 * nrm(ks[5], (L, 4, DA_QK), jnp.float32),
        'diff_subln_g': 1.0 + 0.01 * nrm(ks[6], (L, DA_V), jnp.float32),
        'nat_rpb': 0.1 * nrm(ks[7], (L, HB, 2 * NB_ROWS_MAX - 1, 2 * NB_COLS - 1), jnp.float32),
        'gqa_q_norm_g': 1.0 + 0.01 * nrm(ks[8], (L, HEAD_DIM), jnp.float32),
        'gqa_k_norm_g': 1.0 + 0.01 * nrm(ks[9], (L, HEAD_DIM), jnp.float32),
        'w_branch': nrm(ks[10], (L, N_BRANCH, BRANCH_W, D), jnp.float32) * (BRANCH_W ** -0.5) * DN_BETA,
        'w_out': nrm(ks[11], (L, D, D), jnp.float32) * (D ** -0.5) * DN_BETA,
        'ln_g': 1.0 + 0.01 * nrm(ks[12], (L, D), jnp.float32),
        'ln_b': 0.01 * nrm(ks[13], (L, D), jnp.float32),
    }


def reference(x, emb_ln_g, emb_ln_b, w_in, b_gate, diff_lambda, diff_subln_g, nat_rpb,
              gqa_q_norm_g, gqa_k_norm_g, w_branch, w_out, ln_g, ln_b):
    x = _layer_norm(x, emb_ln_g, emb_ln_b)
    for l in range(DEPTH):
        lam_init = 0.8 - 0.6 * math.exp(-0.3 * l)
        x = _hybrid_layer(x, w_in[l], b_gate[l], diff_lambda[l], diff_subln_g[l], nat_rpb[l],
                          gqa_q_norm_g[l], gqa_k_norm_g[l], w_branch[l], w_out[l], ln_g[l], ln_b[l], lam_init)
    return x
```

```cpp
#include <hip/hip_runtime.h>
#include <hip/hip_bf16.h>
#include <hip/hip_cooperative_groups.h>
#include <cstdio>
#include <cstdint>
namespace cg = cooperative_groups;

#define LAS __attribute__((address_space(3)))
#define DI __device__ __forceinline__
typedef unsigned short u16;
using bf16x8 = __attribute__((ext_vector_type(8))) short;
using s16x4  = __attribute__((ext_vector_type(4))) short;
using f32x4  = __attribute__((ext_vector_type(4))) float;
using f32x16 = __attribute__((ext_vector_type(16))) float;
using u32x4  = __attribute__((ext_vector_type(4))) unsigned;
using u32x2  = __attribute__((ext_vector_type(2))) unsigned;

constexpr int S = 8192, DM = 2048, DIN = 18944, NL = 4;
constexpr int C_AQ = 0, C_AK = 512, C_AV = 1024, C_AZ = 1536, C_BQ = 2048, C_BK = 2560, C_BV = 3072, C_BZ = 3584,
              C_CQ = 4096, C_CK = 4608, C_CV = 4864, C_CZ = 5120, C_DQ = 5632, C_DK = 7168, C_DV = 8704, C_DZ = 10240, C_GL = 10752;
constexpr int NTHR = 512;
constexpr int LDS_BYTES = 131072 + 16 + 256;

constexpr size_t WS_WIN = 0;
constexpr size_t WS_WB  = WS_WIN + (size_t)NL * DIN * DM * 2;
constexpr size_t WS_WO  = WS_WB + (size_t)NL * 4 * DM * 512 * 2;
constexpr size_t WS_X   = WS_WO + (size_t)NL * DM * DM * 2;
constexpr size_t WS_XB  = WS_X + (size_t)S * DM * 4;
constexpr size_t WS_H   = WS_XB + (size_t)S * DM * 2;
constexpr size_t WS_YS  = WS_H + (size_t)S * DIN * 2;
constexpr size_t WS_OD  = WS_YS + (size_t)S * DM * 2;
constexpr size_t WS_LSE = WS_OD + (size_t)3 * S * 512 * 2;
constexpr size_t WS_MACC = WS_LSE + (size_t)3 * S * 4 * 4;
constexpr size_t WS_MB  = WS_MACC + (size_t)S * DM * 4;
constexpr size_t WS_STASH = WS_MB + (size_t)S * DM * 2;
constexpr size_t WS_TA = WS_STASH + (size_t)256 * 64 * 512 * 4;
constexpr size_t WS_TD = WS_TA + (size_t)S * 8 * 2 * 4;
constexpr size_t WS_TC = WS_TD + (size_t)S * 16 * 2 * 4;
constexpr size_t WS_BAR = WS_TC + (size_t)128 * 32 * 2 * 4;
constexpr size_t WS_LNC = WS_BAR + 16384;
constexpr size_t WS_LNS = WS_LNC + (size_t)NL * 32 * 256;
constexpr size_t WS_END = WS_LNS + (size_t)NL * 32 * 8 * 256 * 2 * 4;

struct Params {
  const float* x; const float* emb_g; const float* emb_b; const float* w_in; const float* b_gate; const float* lam; const float* subln_g;
  const float* rpb; const float* qn_g; const float* kn_g; const float* w_branch; const float* w_out; const float* ln_g; const float* ln_b;
  float* out; char* ws;
  int ph_lo, ph_hi;
  DI u16* WinT() const { return (u16*)(ws + WS_WIN); }
  DI u16* WbT() const { return (u16*)(ws + WS_WB); }
  DI u16* WoT() const { return (u16*)(ws + WS_WO); }
  DI float* X() const { return (float*)(ws + WS_X); }
  DI u16* Xb() const { return (u16*)(ws + WS_XB); }
  DI u16* hb() const { return (u16*)(ws + WS_H); }
  DI u16* ys() const { return (u16*)(ws + WS_YS); }
  DI u16* od() const { return (u16*)(ws + WS_OD); }
  DI float* lse() const { return (float*)(ws + WS_LSE); }
  DI float* macc() const { return (float*)(ws + WS_MACC); }
  DI u16* mb() const { return (u16*)(ws + WS_MB); }
  DI float* stash() const { return (float*)(ws + WS_STASH); }
  DI float* tA() const { return (float*)(ws + WS_TA); }
  DI float* tD() const { return (float*)(ws + WS_TD); }
  DI float* tC() const { return (float*)(ws + WS_TC); }
};

extern __shared__ __attribute__((aligned(16))) char shm_[];
DI int hw_slot() { return (int)(__builtin_amdgcn_s_getreg((5 << 11) | 4) & 63u); }
DI int otid() {
  volatile LAS int* wtab = (volatile LAS int*)((LAS char*)shm_ + 131072 + 16);
  const int wv = __builtin_amdgcn_readfirstlane(wtab[hw_slot()]) & 7;
  int t = wv * 64 + (int)__builtin_amdgcn_mbcnt_hi(~0u, __builtin_amdgcn_mbcnt_lo(~0u, 0u));
  asm volatile("" : "+v"(t));
  return t & 511;
}
DI unsigned cvtpk(float lo, float hi) { unsigned r; asm volatile("v_cvt_pk_bf16_f32 %0, %1, %2" : "=v"(r) : "v"(lo), "v"(hi)); return r; }
DI float bf2f(u16 v) { return __uint_as_float(((unsigned)v) << 16); }
DI float bflo(unsigned w) { return __uint_as_float(w << 16); }
DI float bfhi(unsigned w) { return __uint_as_float(w & 0xffff0000u); }
DI u16 f2bf(float x) { return (u16)(cvtpk(x, x) & 0xffffu); }
DI float sigmoidf_(float x) { return __builtin_amdgcn_rcpf(1.f + __expf(-x)); }
DI float siluf_(float x) { return x * sigmoidf_(x); }
DI u32x4 pack8(const float (&v)[8]) { u32x4 w = {cvtpk(v[0], v[1]), cvtpk(v[2], v[3]), cvtpk(v[4], v[5]), cvtpk(v[6], v[7])}; return w; }
DI void unpack8(u32x4 w, float (&v)[8]) { v[0] = bflo(w[0]); v[1] = bfhi(w[0]); v[2] = bflo(w[1]); v[3] = bfhi(w[1]); v[4] = bflo(w[2]); v[5] = bfhi(w[2]); v[6] = bflo(w[3]); v[7] = bfhi(w[3]); }

DI void phase_transpose(const float* __restrict__ src, u16* __restrict__ dst, int K, int N, int nmat, LAS char* lds) {
  const int tid = otid();
  const int tk = K / 128, tn = N / 64; const int per = tk * tn; const long ntiles = (long)nmat * per;
  LAS unsigned* T = (LAS unsigned*)lds;
  for (long t = blockIdx.x; t < ntiles; t += gridDim.x) {
    const int mat = (int)(t / per), rem = (int)(t % per), kt = rem / tn, nt_ = rem % tn;
    const float* s = src + ((long)mat * K + kt * 128) * N + nt_ * 64;
#pragma unroll
    for (int i = 0; i < 2; ++i) {
      const int idx = tid + i * 512, kp = idx >> 4, c4 = idx & 15;
      const float4 a = *(const float4*)(s + (long)(2 * kp) * N + c4 * 4);
      const float4 b = *(const float4*)(s + (long)(2 * kp + 1) * N + c4 * 4);
      T[(c4 * 4 + 0) * 68 + kp] = cvtpk(a.x, b.x);
      T[(c4 * 4 + 1) * 68 + kp] = cvtpk(a.y, b.y);
      T[(c4 * 4 + 2) * 68 + kp] = cvtpk(a.z, b.z);
      T[(c4 * 4 + 3) * 68 + kp] = cvtpk(a.w, b.w);
    }
    __syncthreads();
    u16* d = dst + ((long)mat * N + nt_ * 64) * K + kt * 128;
#pragma unroll
    for (int i = 0; i < 2; ++i) {
      const int idx = tid + i * 512, nr = idx >> 4, ch = idx & 15;
      const u32x4 v = *(LAS const u32x4*)(T + nr * 68 + ch * 4);
      *(u32x4*)(d + (long)nr * K + ch * 8) = v;
    }
    __syncthreads();
  }
}

template <int M> DI float shx(float v) { return __int_as_float(__builtin_amdgcn_ds_swizzle(__float_as_int(v), (M << 10) | 0x1f)); }
DI float sum16(float v) { v += shx<8>(v); v += shx<4>(v); v += shx<2>(v); v += shx<1>(v); return v; }
DI float sum32(float v) { v += shx<16>(v); return sum16(v); }
DI float wave_sum(float v) {
  v = sum32(v);
  auto rr = __builtin_amdgcn_permlane32_swap(__float_as_uint(v), __float_as_uint(v), false, false);
  return __uint_as_float(rr[0]) + __uint_as_float(rr[1]);
}
DI void phase_ln(const float* __restrict__ src, const float* __restrict__ g, const float* __restrict__ b, float* __restrict__ dstf, u16* __restrict__ dstb) {
  const int tid = otid(), wid = tid >> 6, lane = tid & 63;
  for (int row = blockIdx.x * 8 + wid; row < S; row += gridDim.x * 8) {
    const float* sr = src + (long)row * DM;
    float4 v[8]; float sum = 0.f;
#pragma unroll
    for (int j = 0; j < 8; ++j) { v[j] = *(const float4*)(sr + (j * 64 + lane) * 4); sum += v[j].x + v[j].y + v[j].z + v[j].w; }
    const float mu = wave_sum(sum) * (1.f / DM);
    float sq = 0.f;
#pragma unroll
    for (int j = 0; j < 8; ++j) { v[j].x -= mu; v[j].y -= mu; v[j].z -= mu; v[j].w -= mu; sq += v[j].x * v[j].x + v[j].y * v[j].y + v[j].z * v[j].z + v[j].w * v[j].w; }
    const float rs = rsqrtf(wave_sum(sq) * (1.f / DM) + 1e-5f);
#pragma unroll
    for (int j = 0; j < 8; ++j) {
      const int c = (j * 64 + lane) * 4;
      const float4 gg = *(const float4*)(g + c), bb = *(const float4*)(b + c);
      float4 y; y.x = v[j].x * rs * gg.x + bb.x; y.y = v[j].y * rs * gg.y + bb.y; y.z = v[j].z * rs * gg.z + bb.z; y.w = v[j].w * rs * gg.w + bb.w;
      *(float4*)(dstf + (long)row * DM + c) = y;
      if (dstb) { u32x2 w = {cvtpk(y.x, y.y), cvtpk(y.z, y.w)}; *(u32x2*)(dstb + (long)row * DM + c) = w; }
    }
  }
}

DI int lds_byte(int r, int c) { int st = (r >> 4) * 2 + (c >> 5), rr = r & 15, cc = c & 31, ob = rr * 64 + cc * 2; return st * 1024 + (ob ^ (((ob >> 9) & 1) << 5)); }
DI void stage_rc(int b, int& R, int& C) { int st = b / 1024, sb = b % 1024, swz = sb ^ (((sb >> 9) & 1) << 5); R = (st >> 1) * 16 + swz / 64; C = (st & 1) * 32 + (swz % 64) / 2; }

DI void tile_order(int L, int nM, int nN, int& pm, int& pn) {
  const int nwg = nM * nN; int wgid = L;
  { const int q = nwg / 8, r = nwg % 8, xcd = wgid % 8, off = wgid / 8; wgid = (xcd < r ? xcd * (q + 1) : r * (q + 1) + (xcd - r) * q) + off; }
  const int nig = 8 * nN, gid = wgid / nig, fm = gid * 8, gsz = (nM - fm) < 8 ? (nM - fm) : 8;
  pm = fm + ((wgid % nig) % gsz); pn = (wgid % nig) / gsz;
}

struct NoHook { DI void operator()(int, f32x4 (&)[2][2][4][2], int, int, int, int, int, int) const {} };
template <class Epi, class Hook>
DI void gemm_tile(const u16* __restrict__ A, int lda, const u16* __restrict__ Bt, int ldb, int K, int brow, int bcol, const Epi& epi, const Hook& hook, LAS char* shm,
               bool pre = false, int nbrow = -1, int nbcol = 0) {
  const int tid = otid();
  int R0, C0, R1, C1; stage_rc(tid * 16, R0, C0); stage_rc(tid * 16 + 8192, R1, C1);
  const int R0b = (R0 & ~31) + 8 * ((R0 & 15) >> 2) + 4 * ((R0 >> 4) & 1) + (R0 & 3), R1b = (R1 & ~31) + 8 * ((R1 & 15) >> 2) + 4 * ((R1 >> 4) & 1) + (R1 & 3);
  const unsigned oa0 = (unsigned)(R0 * lda + C0) * 2u, oa1 = (unsigned)(R1 * lda + C1) * 2u, ob0 = (unsigned)(R0b * ldb + C0) * 2u, ob1 = (unsigned)(R1b * ldb + C1) * 2u;
#define SA(b, h) (shm + ((b) * 2 + (h)) * 16384)
#define SB(b, h) (shm + (4 + (b) * 2 + (h)) * 16384)
#define STAGE_A(P, br, kt) do { const char* _g = (const char*)(A + (long)(br) * lda + (long)(kt) * 64); \
    __builtin_amdgcn_global_load_lds((const unsigned*)(_g + oa0), (LAS unsigned*)((P) + tid * 16), 16, 0, 0); \
    __builtin_amdgcn_global_load_lds((const unsigned*)(_g + oa1), (LAS unsigned*)((P) + tid * 16 + 8192), 16, 0, 0); } while (0)
#define STAGE_B(P, bc, kt) do { const char* _g = (const char*)(Bt + (long)(bc) * ldb + (long)(kt) * 64); \
    __builtin_amdgcn_global_load_lds((const unsigned*)(_g + ob0), (LAS unsigned*)((P) + tid * 16), 16, 0, 0); \
    __builtin_amdgcn_global_load_lds((const unsigned*)(_g + ob1), (LAS unsigned*)((P) + tid * 16 + 8192), 16, 0, 0); } while (0)
#define LDA(dst, b, h) _Pragma("unroll") for (int m = 0; m < 4; ++m) _Pragma("unroll") for (int k = 0; k < 2; ++k) \
    dst[m][k] = *(LAS const bf16x8*)(SA(b, h) + aoff + m * 2048 + k * 1024)
#define LDB(dst, b, h) _Pragma("unroll") for (int n = 0; n < 2; ++n) _Pragma("unroll") for (int k = 0; k < 2; ++k) \
    dst[n][k] = *(LAS const bf16x8*)(SB(b, h) + boff + n * 2048 + k * 1024)
#define MMA(ai, bj, At_, Bt_) do { __builtin_amdgcn_s_setprio(1); \
    _Pragma("unroll") for (int m = 0; m < 4; ++m) _Pragma("unroll") for (int n = 0; n < 2; ++n) _Pragma("unroll") for (int k = 0; k < 2; ++k) \
      acc[ai][bj][m][n] = __builtin_amdgcn_mfma_f32_16x16x32_bf16(Bt_[n][k], At_[m][k], acc[ai][bj][m][n], 0, 0, 0); \
    __builtin_amdgcn_s_setprio(0); } while (0)
#define WAIT_V(n) asm volatile("s_waitcnt vmcnt(" #n ")" ::: "memory")
#define WAIT_L(n) asm volatile("s_waitcnt lgkmcnt(" #n ")" ::: "memory")
#define BAR __builtin_amdgcn_s_barrier()
#define SCHED __builtin_amdgcn_sched_barrier(0)
  const int wid = tid >> 6, lane = tid & 63, wr = wid >> 2, wc = wid & 3, fr = lane & 15, fq = lane >> 4;
  const int fsw = lds_byte(fr, fq * 8), aoff = wr * 8192 + fsw, boff = wc * 4096 + fsw;
  f32x4 acc[2][2][4][2] = {};
  bf16x8 At[4][2], B0[2][2], B1[2][2];
  const int nt = K / 64;
  if (!pre) {
    STAGE_B(SB(0, 0), bcol, 0); STAGE_A(SA(0, 0), brow, 0);
    STAGE_B(SB(0, 1), bcol + 128, 0); STAGE_A(SA(0, 1), brow + 128, 0);
  }
  if (wr == 1) BAR;
  WAIT_V(4); BAR;
  STAGE_B(SB(1, 0), bcol, 1); STAGE_A(SA(1, 0), brow, 1); STAGE_B(SB(1, 1), bcol + 128, 1);
  WAIT_V(6); BAR;
#pragma unroll 1
  for (int t = 0; t < nt - 2; t += 2) {
    hook(t, acc, brow, bcol, wr, wc, fr, fq);
    LDB(B0, 0, 0); SCHED; LDA(At, 0, 0); STAGE_A(SA(1, 1), brow + 128, t + 1);
    WAIT_L(8); BAR; WAIT_L(0); MMA(0, 0, At, B0); BAR; SCHED;
    LDB(B1, 0, 1); STAGE_B(SB(0, 0), bcol, t + 2);
    BAR; WAIT_L(0); MMA(0, 1, At, B1); BAR;
    LDA(At, 0, 1); STAGE_A(SA(0, 0), brow, t + 2);
    BAR; WAIT_L(0); MMA(1, 0, At, B0); BAR; SCHED;
    STAGE_B(SB(0, 1), bcol + 128, t + 2);
    WAIT_V(6); BAR; MMA(1, 1, At, B1); BAR;
    LDB(B0, 1, 0); SCHED; LDA(At, 1, 0); STAGE_A(SA(0, 1), brow + 128, t + 2);
    WAIT_L(8); BAR; WAIT_L(0); MMA(0, 0, At, B0); BAR; SCHED;
    LDB(B1, 1, 1); STAGE_B(SB(1, 0), bcol, t + 3);
    BAR; WAIT_L(0); MMA(0, 1, At, B1); BAR;
    LDA(At, 1, 1); STAGE_A(SA(1, 0), brow, t + 3);
    BAR; WAIT_L(0); MMA(1, 0, At, B0); BAR; SCHED;
    STAGE_B(SB(1, 1), bcol + 128, t + 3);
    WAIT_V(6); BAR; MMA(1, 1, At, B1); BAR;
  }
  { LDB(B0, 0, 0); LDA(At, 0, 0); STAGE_A(SA(1, 1), brow + 128, nt - 1);
    BAR; WAIT_L(0); MMA(0, 0, At, B0); BAR;
    LDB(B1, 0, 1); BAR; WAIT_L(0); MMA(0, 1, At, B1); BAR;
    LDA(At, 0, 1); WAIT_V(4); BAR; WAIT_L(0); MMA(1, 0, At, B0); MMA(1, 1, At, B1); BAR; }
  { LDB(B0, 1, 0); LDA(At, 1, 0); WAIT_V(2); BAR; WAIT_L(0); MMA(0, 0, At, B0); BAR;
    LDB(B1, 1, 1); WAIT_V(0); BAR; WAIT_L(0); MMA(0, 1, At, B1); BAR;
    LDA(At, 1, 1); BAR; WAIT_L(0); MMA(1, 0, At, B0); MMA(1, 1, At, B1); BAR; }
  if (wr == 0) BAR;
  if (nbrow >= 0) {
    STAGE_B(SB(0, 0), nbcol, 0); STAGE_A(SA(0, 0), nbrow, 0);
    STAGE_B(SB(0, 1), nbcol + 128, 0); STAGE_A(SA(0, 1), nbrow + 128, 0);
  }
  if constexpr (Epi::TILE) { epi.tile(acc, brow, bcol, wr, wc, fr, fq, shm); } else {
#pragma unroll
  for (int ai = 0; ai < 2; ++ai)
#pragma unroll
    for (int m = 0; m < 4; ++m) {
#pragma unroll
      for (int bj = 0; bj < 2; ++bj)
        epi(brow + ai * 128 + wr * 64 + m * 16 + fr, bcol + bj * 128 + wc * 32 + fq * 8, acc[ai][bj][m][0], acc[ai][bj][m][1]);
      if (((ai * 4 + m) % Epi::GRP) == Epi::GRP - 1) SCHED;
    }
  }
  __syncthreads();
#undef SA
#undef SB
#undef STAGE_A
#undef STAGE_B
#undef LDA
#undef LDB
#undef MMA
}

DI void unpack8f(u32x4 w, f32x4& a, f32x4& b) { a[0] = bflo(w[0]); a[1] = bfhi(w[0]); a[2] = bflo(w[1]); a[3] = bfhi(w[1]); b[0] = bflo(w[2]); b[1] = bfhi(w[2]); b[2] = bflo(w[3]); b[3] = bfhi(w[3]); }
struct EpiH {
  static constexpr bool TILE = false; static constexpr int GRP = 1;
  u16* hb; const float* bg; int kind;
  DI void operator()(int row, int col, f32x4 v0, f32x4 v1) const {
    if (kind == 2) {
      const f32x4 b0 = *(const f32x4*)(bg + (col - C_GL)), b1 = *(const f32x4*)(bg + (col - C_GL) + 4);
#pragma unroll
      for (int j = 0; j < 4; ++j) { v0[j] = sigmoidf_(v0[j] + b0[j]); v1[j] = sigmoidf_(v1[j] + b1[j]); }
    } else if (kind == 1) {
#pragma unroll
      for (int j = 0; j < 4; ++j) { v0[j] = siluf_(v0[j]); v1[j] = siluf_(v1[j]); }
    }
    u32x4 w = {cvtpk(v0[0], v0[1]), cvtpk(v0[2], v0[3]), cvtpk(v1[0], v1[1]), cvtpk(v1[2], v1[3])};
    *(u32x4*)(hb + (long)row * DIN + col) = w;
  }
};
#ifndef HGRP
#define HGRP 4
#endif
struct GateHook {
  const u16* hb;
  DI void operator()(int t, f32x4 (&acc)[2][2][4][2], int brow, int bcol, int wr, int wc, int fr, int fq) const {
    if (t == 8 || t == 16 || t == 24) {
      const int n = (t >> 3) - 1;
      int fr_ = fr; asm volatile("" : "+v"(fr_));
      const u16* gp = hb + (long)(brow + wr * 64 + fr_) * DIN + C_GL + n * DM + bcol + wc * 32 + fq * 8;
#pragma unroll
      for (int ai = 0; ai < 2; ++ai)
#pragma unroll
        for (int mh = 0; mh < 4; mh += HGRP) {
          u32x4 wa[HGRP][2], wb[HGRP][2];
#pragma unroll
          for (int q = 0; q < HGRP; ++q) {
            const u16* rp = gp + (long)(ai * 128 + (mh + q) * 16) * DIN;
#pragma unroll
            for (int bj = 0; bj < 2; ++bj) { wa[q][bj] = *(const u32x4*)(rp + bj * 128); wb[q][bj] = *(const u32x4*)(rp + DM + bj * 128); }
          }
          __builtin_amdgcn_sched_barrier(0);
#pragma unroll
          for (int q = 0; q < HGRP; ++q)
#pragma unroll
            for (int bj = 0; bj < 2; ++bj) {
              f32x4 g00, g01, g10, g11; unpack8f(wa[q][bj], g00, g01); unpack8f(wb[q][bj], g10, g11);
#pragma unroll
              for (int j = 0; j < 4; ++j) {
                acc[ai][bj][mh + q][0][j] *= g00[j] * __builtin_amdgcn_rcpf(fmaxf(g10[j], 1e-30f));
                acc[ai][bj][mh + q][1][j] *= g01[j] * __builtin_amdgcn_rcpf(fmaxf(g11[j], 1e-30f));
              }
            }
          __builtin_amdgcn_sched_barrier(0);
        }
    }
  }
};
struct EpiBrF {
  static constexpr bool TILE = true; static constexpr int GRP = 1;
  const u16* hb; u16* mb;
  DI void tile(f32x4 (&acc)[2][2][4][2], int brow, int bcol, int wr, int wc, int fr, int fq, LAS char* lds) const {
    int fr_ = fr; asm volatile("" : "+v"(fr_));
    const long r0 = brow + wr * 64 + fr_; const int c0 = bcol + wc * 32 + fq * 8;
    const u16* gp = hb + r0 * DIN + C_GL + 3 * DM + c0;
    u16* op = mb + r0 * DM + c0;
#pragma unroll
    for (int ai = 0; ai < 2; ++ai)
#pragma unroll
      for (int mh = 0; mh < 4; mh += HGRP) {
        u32x4 wg[HGRP][2];
#pragma unroll
        for (int q = 0; q < HGRP; ++q)
#pragma unroll
          for (int bj = 0; bj < 2; ++bj) wg[q][bj] = *(const u32x4*)(gp + (long)(ai * 128 + (mh + q) * 16) * DIN + bj * 128);
        __builtin_amdgcn_sched_barrier(0);
#pragma unroll
        for (int q = 0; q < HGRP; ++q)
#pragma unroll
          for (int bj = 0; bj < 2; ++bj) {
            f32x4 g0, g1; unpack8f(wg[q][bj], g0, g1);
            const f32x4 v0 = acc[ai][bj][mh + q][0] * g0, v1 = acc[ai][bj][mh + q][1] * g1;
            u32x4 w = {cvtpk(v0[0], v0[1]), cvtpk(v0[2], v0[3]), cvtpk(v1[0], v1[1]), cvtpk(v1[2], v1[3])};
            *(u32x4*)(op + (long)(ai * 128 + (mh + q) * 16) * DM + bj * 128) = w;
          }
        __builtin_amdgcn_sched_barrier(0);
      }
  }
};
struct EpiOutLN {
  static constexpr bool TILE = true; static constexpr int GRP = 1;
  float* X; u16* Xb; float* outp; const float* g; const float* b; float* stats; unsigned* cnt; float alpha; int last, pm, pn;
  DI void tile(f32x4 (&acc)[2][2][4][2], int brow, int bcol, int wr, int wc, int fr, int fq, LAS char* lds) const {
    LAS float* red = (LAS float*)lds;
    LAS float* rst = (LAS float*)(lds + 8192);
    { int fr_ = fr; asm volatile("" : "+v"(fr_));
      const float* xb = X + (long)(brow + wr * 64 + fr_) * DM + bcol + wc * 32 + fq * 8;
#pragma unroll
      for (int ai = 0; ai < 2; ++ai)
#pragma unroll
        for (int mh = 0; mh < 4; mh += 2) {
          f32x4 xr[2][2][2];
#pragma unroll
          for (int q = 0; q < 2; ++q)
#pragma unroll
            for (int bj = 0; bj < 2; ++bj) { const f32x4* xp = (const f32x4*)(xb + (long)(ai * 128 + (mh + q) * 16) * DM + bj * 128); xr[q][bj][0] = xp[0]; xr[q][bj][1] = xp[1]; }
          __builtin_amdgcn_sched_barrier(0);
#pragma unroll
          for (int q = 0; q < 2; ++q) {
            const int m = mh + q; const int rl = ai * 128 + wr * 64 + m * 16 + fr; float sm = 0.f, sq = 0.f;
#pragma unroll
            for (int bj = 0; bj < 2; ++bj) {
              const f32x4 y0 = alpha * xr[q][bj][0] + acc[ai][bj][m][0], y1 = alpha * xr[q][bj][1] + acc[ai][bj][m][1];
              acc[ai][bj][m][0] = y0; acc[ai][bj][m][1] = y1;
#pragma unroll
              for (int j = 0; j < 4; ++j) { sm += y0[j] + y1[j]; sq += y0[j] * y0[j] + y1[j] * y1[j]; }
            }
            sm += shx<16>(sm); sq += shx<16>(sq);
            { auto r0 = __builtin_amdgcn_permlane32_swap(__float_as_uint(sm), __float_as_uint(sm), false, false); sm = __uint_as_float(r0[0]) + __uint_as_float(r0[1]);
              auto r1 = __builtin_amdgcn_permlane32_swap(__float_as_uint(sq), __float_as_uint(sq), false, false); sq = __uint_as_float(r1[0]) + __uint_as_float(r1[1]); }
            if (fq == 0) { red[(rl * 4 + wc) * 2] = sm; red[(rl * 4 + wc) * 2 + 1] = sq; }
          }
          SCHED;
        }
    }
    __syncthreads();
    const int tid = otid();
    float* st = stats + ((long)(pm * 8) * 256) * 2;
    if (tid < 256) {
      float s4 = 0.f, q4 = 0.f;
#pragma unroll
      for (int w = 0; w < 4; ++w) { s4 += red[(tid * 4 + w) * 2]; q4 += red[(tid * 4 + w) * 2 + 1]; }
      __hip_atomic_store(st + ((long)pn * 256 + tid) * 2, s4, __ATOMIC_RELAXED, __HIP_MEMORY_SCOPE_AGENT);
      __hip_atomic_store(st + ((long)pn * 256 + tid) * 2 + 1, q4, __ATOMIC_RELAXED, __HIP_MEMORY_SCOPE_AGENT);
    }
    asm volatile("s_waitcnt vmcnt(0)" ::: "memory");
    __syncthreads();
    if (tid == 0) {
      unsigned* c = cnt + pm * 64;
      __builtin_amdgcn_fence(__ATOMIC_RELEASE, "agent");
      asm volatile("s_waitcnt vmcnt(0)" ::: "memory");
      (void)__hip_atomic_fetch_add(c, 1u, __ATOMIC_RELAXED, __HIP_MEMORY_SCOPE_AGENT);
      unsigned sp = 0;
      while (__hip_atomic_load(c, __ATOMIC_RELAXED, __HIP_MEMORY_SCOPE_AGENT) < 8u) { __builtin_amdgcn_s_sleep(1); if (++sp > (1u << 22)) break; }
      __builtin_amdgcn_fence(__ATOMIC_ACQUIRE, "agent");
      asm volatile("s_waitcnt vmcnt(0)" ::: "memory");
    }
    __syncthreads();
    if (tid < 256) {
      float s8 = 0.f, q8 = 0.f;
#pragma unroll
      for (int j = 0; j < 8; ++j) { s8 += __hip_atomic_load(st + ((long)j * 256 + tid) * 2, __ATOMIC_RELAXED, __HIP_MEMORY_SCOPE_AGENT); q8 += __hip_atomic_load(st + ((long)j * 256 + tid) * 2 + 1, __ATOMIC_RELAXED, __HIP_MEMORY_SCOPE_AGENT); }
      const float mu = s8 * (1.f / DM); const float var = fmaxf(q8 * (1.f / DM) - mu * mu, 0.f);
      rst[tid * 2] = mu; rst[tid * 2 + 1] = rsqrtf(var + 1e-5f);
    }
    __syncthreads();
#pragma unroll
    for (int ai = 0; ai < 2; ++ai)
#pragma unroll
      for (int m = 0; m < 4; ++m) {
        const int rl = ai * 128 + wr * 64 + m * 16 + fr; const float mu = rst[rl * 2], rs = rst[rl * 2 + 1];
#pragma unroll
        for (int bj = 0; bj < 2; ++bj) {
          const int col = bcol + bj * 128 + wc * 32 + fq * 8;
          const f32x4 g0 = *(const f32x4*)(g + col), g1 = *(const f32x4*)(g + col + 4), b0 = *(const f32x4*)(b + col), b1 = *(const f32x4*)(b + col + 4);
          f32x4 v0 = (acc[ai][bj][m][0] - mu) * rs * g0 + b0, v1 = (acc[ai][bj][m][1] - mu) * rs * g1 + b1;
          if (last) { f32x4* op = (f32x4*)(outp + (long)(brow + rl) * DM + col); op[0] = v0; op[1] = v1; }
          else {
            f32x4* xp = (f32x4*)(X + (long)(brow + rl) * DM + col); xp[0] = v0; xp[1] = v1;
            u32x4 w = {cvtpk(v0[0], v0[1]), cvtpk(v0[2], v0[3]), cvtpk(v1[0], v1[1]), cvtpk(v1[2], v1[3])};
            *(u32x4*)(Xb + (long)(brow + rl) * DM + col) = w;
          }
        }
        SCHED;
      }
  }
};

DI void phase_tables(const Params& p) {
  const int gt = blockIdx.x * NTHR + otid(), gn = gridDim.x * NTHR;
  for (int e = gt; e < S * 8; e += gn) { const int t = e >> 3, i = e & 7; float sn, cs; sincosf((float)t * powf(500000.f, -(float)i * (1.f / 8.f)), &sn, &cs); p.tA()[e] = cs; p.tA()[S * 8 + e] = sn; }
  for (int e = gt; e < S * 16; e += gn) { const int t = e >> 4, i = e & 15; float sn, cs; sincosf((float)t * powf(500000.f, -(float)i * (1.f / 16.f)), &sn, &cs); p.tD()[e] = cs; p.tD()[S * 16 + e] = sn; }
  for (int e = gt; e < 128 * 32; e += gn) { const int t = e >> 5, i = e & 31; float sn, cs; sincosf((float)t * powf(10000.f, -(float)i * (1.f / 32.f)), &sn, &cs); p.tC()[e] = cs; p.tC()[128 * 32 + e] = sn; }
}
DI void ld8f(const float* q, float (&v)[8]) { const f32x4 a = *(const f32x4*)q, b = *(const f32x4*)(q + 4); v[0] = a[0]; v[1] = a[1]; v[2] = a[2]; v[3] = a[3]; v[4] = b[0]; v[5] = b[1]; v[6] = b[2]; v[7] = b[3]; }
DI void phase_prep(const Params& p, int l) {
  const int tid = otid(), wid = tid >> 6, lane = tid & 63;
  const float* qg = p.qn_g + l * 128; const float* kg = p.kn_g + l * 128;
  for (int t = blockIdx.x * 8 + wid; t < S; t += gridDim.x * 8) {
    u16* hr = p.hb() + (long)t * DIN;
    {
      int base, off2; const float* ct; const float* st_;
      if (lane < 16) { base = (lane < 8) ? (C_AQ + lane * 64) : (C_AK + (lane - 8) * 64); off2 = 8; ct = p.tA() + t * 8; st_ = ct + S * 8; }
      else { const int k = lane - 16, v = k >> 1, hf = k & 1; base = ((v < 12) ? (C_DQ + v * 128) : (C_DK + (v - 12) * 128)) + hf * 8; off2 = 16; ct = p.tD() + t * 16 + hf * 8; st_ = ct + S * 16; }
      float x1[8], x2[8], cs[8], sn[8], o1[8], o2[8];
      unpack8(*(const u32x4*)(hr + base), x1); unpack8(*(const u32x4*)(hr + base + off2), x2); ld8f(ct, cs); ld8f(st_, sn);
#pragma unroll
      for (int i = 0; i < 8; ++i) { o1[i] = x1[i] * cs[i] - x2[i] * sn[i]; o2[i] = x2[i] * cs[i] + x1[i] * sn[i]; }
      *(u32x4*)(hr + base) = pack8(o1); *(u32x4*)(hr + base + off2) = pack8(o2);
    }
#pragma unroll
    for (int ps = 0; ps < 2; ++ps) {
      const int v = ps * 4 + (lane >> 4), c = lane & 15;
      if (v < 6) {
        const int base = ((v < 4) ? (C_CQ + v * 128) : (C_CK + (v - 4) * 128)) + c * 8;
        float x[8], g[8], cs[8], sn[8], pr[8], o[8];
        unpack8(*(const u32x4*)(hr + base), x);
        float ss = 0.f;
#pragma unroll
        for (int i = 0; i < 8; ++i) ss += x[i] * x[i];
        ss = sum16(ss);
        const float rs = rsqrtf(ss * (1.f / 128.f) + 1e-6f);
        ld8f(((v < 4) ? qg : kg) + c * 8, g);
        const float* ct = p.tC() + ((c < 8) ? (t >> 6) : (t & 63)) * 32 + (c & 3) * 8;
        ld8f(ct, cs); ld8f(ct + 128 * 32, sn);
#pragma unroll
        for (int i = 0; i < 8; ++i) { x[i] *= rs * g[i]; pr[i] = shx<4>(x[i]); }
        const float sg = (c & 4) ? 1.f : -1.f;
#pragma unroll
        for (int i = 0; i < 8; ++i) o[i] = x[i] * cs[i] + sg * pr[i] * sn[i];
        *(u32x4*)(hr + base) = pack8(o);
      }
    }
  }
}

constexpr float THR = 8.f;
DI int crow(int r, int hi) { return (r & 3) + 8 * (r >> 2) + 4 * hi; }
struct MaskArgs { int u0, u1, u2; int v0, v1; LAS const float* tbl; };
template <int MODE>
DI void mask_apply(f32x16& p0, f32x16& p1, int j, const MaskArgs& ma) {
  if constexpr (MODE == 1) {
    const int rp = ma.u0 + j; const bool rv = (rp >= ma.u1) && (rp < ma.u1 + 8);
    if (rv) {
      LAS const float* tp = ma.tbl + ((rp - ma.u2 + 7) * 31 + ma.v0);
      const int cb = ma.v1;
#pragma unroll
      for (int r = 0; r < 16; ++r) {
        const int cc = (r & 3) + 8 * (r >> 2);
        p0[r] = ((unsigned)(cc + cb) < 16u) ? (p0[r] + tp[cc]) : -2e30f;
        p1[r] = ((unsigned)(cc + 32 + cb) < 16u) ? (p1[r] + tp[cc + 32]) : -2e30f;
      }
    } else {
#pragma unroll
      for (int r = 0; r < 16; ++r) { p0[r] = -2e30f; p1[r] = -2e30f; }
    }
  } else if constexpr (MODE == 2) {
    const int base = ma.v0 + j * 64;
#pragma unroll
    for (int r = 0; r < 16; ++r) {
      const int cc = (r & 3) + 8 * (r >> 2);
      p0[r] = ((unsigned)(base + cc) <= 128u) ? p0[r] : -2e30f;
      p1[r] = ((unsigned)(base + cc + 32) <= 128u) ? p1[r] : -2e30f;
    }
  }
}

template <int DQK>
DI void partialSM(f32x16& p0, f32x16& p1, float& m_reg, float& mn, float& alpha) {
  constexpr float SCALE = (DQK == 64) ? 0.125f : 0.088388347648318440f;
  constexpr float C = SCALE * 1.4426950408889634f;
  float pmax = p0[0];
#pragma unroll
  for (int r = 1; r < 16; ++r) pmax = fmaxf(pmax, p0[r]);
#pragma unroll
  for (int r = 0; r < 16; ++r) pmax = fmaxf(pmax, p1[r]);
  { auto rr = __builtin_amdgcn_permlane32_swap(__float_as_uint(pmax), __float_as_uint(pmax), false, false);
    pmax = fmaxf(__uint_as_float(rr[0]), __uint_as_float(rr[1])); }
  if (__builtin_expect(__all(pmax - m_reg <= THR / SCALE), 1)) { mn = m_reg; alpha = 1.f; }
  else { mn = fmaxf(m_reg, pmax); alpha = __builtin_amdgcn_exp2f((m_reg - mn) * C); m_reg = mn; }
  const float mnC = -mn * C;
#pragma unroll
  for (int r = 0; r < 16; ++r) p0[r] = fmaf(p0[r], C, mnC);
#pragma unroll
  for (int r = 0; r < 16; ++r) p1[r] = fmaf(p1[r], C, mnC);
#pragma unroll
  for (int r = 0; r < 16; ++r) p0[r] = __builtin_amdgcn_exp2f(p0[r]);
}
DI void finishSM(f32x16& p0, f32x16& p1, float alpha, float& l_reg, bf16x8& pa0, bf16x8& pa1, bf16x8& pa2, bf16x8& pa3) {
#pragma unroll
  for (int r = 0; r < 16; ++r) p1[r] = __builtin_amdgcn_exp2f(p1[r]);
  float ps = 0;
#pragma unroll
  for (int r = 0; r < 16; ++r) ps += p0[r];
#pragma unroll
  for (int r = 0; r < 16; ++r) ps += p1[r];
  { auto rr = __builtin_amdgcn_permlane32_swap(__float_as_uint(ps), __float_as_uint(ps), false, false);
    ps = __uint_as_float(rr[0]) + __uint_as_float(rr[1]); }
  l_reg = l_reg * alpha + ps;
#define PK4(P, BASE, OUT) do { unsigned a0 = cvtpk(P[BASE + 0], P[BASE + 1]), a1 = cvtpk(P[BASE + 2], P[BASE + 3]);   \
    unsigned b0 = cvtpk(P[BASE + 4], P[BASE + 5]), b1 = cvtpk(P[BASE + 6], P[BASE + 7]);                              \
    auto r0 = __builtin_amdgcn_permlane32_swap(a0, b0, false, false); auto r1 = __builtin_amdgcn_permlane32_swap(a1, b1, false, false); \
    u32x4 w = {r0[0], r1[0], r0[1], r1[1]}; OUT = __builtin_bit_cast(bf16x8, w); } while (0)
  PK4(p0, 0, pa0); PK4(p0, 8, pa1); PK4(p1, 0, pa2); PK4(p1, 8, pa3);
#undef PK4
}
template <int DQK>
DI void qkt(f32x16& p0, f32x16& p1, LAS const char* Ks, const bf16x8* qr, int r32, int hi) {
  p0 = f32x16{}; p1 = f32x16{};
#pragma unroll
  for (int d0 = 0; d0 < DQK / 16; ++d0) {
    const int cb = (d0 * 16 + hi * 8) * 2;
    const bf16x8 b0 = *(LAS const bf16x8*)(Ks + r32 * (DQK * 2) + (cb ^ ((r32 & 7) << 4)));
    const bf16x8 b1 = *(LAS const bf16x8*)(Ks + (32 + r32) * (DQK * 2) + (cb ^ ((r32 & 7) << 4)));
    p0 = __builtin_amdgcn_mfma_f32_32x32x16_bf16(b0, qr[d0], p0, 0, 0, 0);
    p1 = __builtin_amdgcn_mfma_f32_32x32x16_bf16(b1, qr[d0], p1, 0, 0, 0);
  }
}
DI int v_st(int k, int c) { const int kk = (k & ~0xC) | ((k & 4) << 1) | ((k & 8) >> 1); return ((kk >> 3) * 4 + (c >> 5)) * 512 + ((kk & 7) * 32 + (c & 31)) * 2; }
DI int v_rd_base(int lane) { return ((lane & 3) << 3) | (((lane >> 2) & 3) << 6) | (((lane >> 4) & 1) << 5) | (((lane >> 5) & 1) << 8); }
constexpr int v_rd_off(int d0, int ks, int half) { return d0 * 512 + ks * 4096 + half * 2048; }
template <int OFF> DI s16x4 tr_read(int vb) {
  s16x4 r; asm volatile("ds_read_b64_tr_b16 %0, %1 offset:%2" : "=&v"(r) : "v"(vb), "i"(OFF) : "memory"); return r;
}
#define SBAR() __builtin_amdgcn_sched_barrier(0)
template <int D0> DI void pv_one(f32x16& od, int vb, bf16x8 pa0, bf16x8 pa1, bf16x8 pa2, bf16x8 pa3) {
  const s16x4 l0 = tr_read<v_rd_off(D0, 0, 0)>(vb), h0 = tr_read<v_rd_off(D0, 0, 1)>(vb), l1 = tr_read<v_rd_off(D0, 1, 0)>(vb), h1 = tr_read<v_rd_off(D0, 1, 1)>(vb);
  const s16x4 l2 = tr_read<v_rd_off(D0, 2, 0)>(vb), h2 = tr_read<v_rd_off(D0, 2, 1)>(vb), l3 = tr_read<v_rd_off(D0, 3, 0)>(vb), h3 = tr_read<v_rd_off(D0, 3, 1)>(vb);
  asm volatile("s_waitcnt lgkmcnt(0)" ::: "memory"); SBAR();
#define PK(L, H) (bf16x8){L[0], L[1], L[2], L[3], H[0], H[1], H[2], H[3]}
  od = __builtin_amdgcn_mfma_f32_32x32x16_bf16(pa0, PK(l0, h0), od, 0, 0, 0);
  od = __builtin_amdgcn_mfma_f32_32x32x16_bf16(pa1, PK(l1, h1), od, 0, 0, 0);
  od = __builtin_amdgcn_mfma_f32_32x32x16_bf16(pa2, PK(l2, h2), od, 0, 0, 0);
  od = __builtin_amdgcn_mfma_f32_32x32x16_bf16(pa3, PK(l3, h3), od, 0, 0, 0);
#undef PK
}
DI void pv_d0(f32x16* o, int vb, bf16x8 pa0, bf16x8 pa1, bf16x8 pa2, bf16x8 pa3) {
  pv_one<0>(o[0], vb, pa0, pa1, pa2, pa3); pv_one<1>(o[1], vb, pa0, pa1, pa2, pa3); pv_one<2>(o[2], vb, pa0, pa1, pa2, pa3); pv_one<3>(o[3], vb, pa0, pa1, pa2, pa3);
}

template <int DQK, int MODE>
DI void attn_body(const u16* __restrict__ Qb, long ldq, const u16* __restrict__ Kh, const u16* __restrict__ Vh, long ldk, int NT,
                  LAS char* lds, const MaskArgs& ma, f32x16 (&o)[4], float& lse_out) {
  constexpr float SCALE = (DQK == 64) ? 0.125f : 0.088388347648318440f;
  constexpr int SHM_V = 16384, SHM_K = 64 * DQK * 2, ND = DQK / 16;
  const int tid = otid(), wid = tid >> 6, lane = tid & 63, r32 = lane & 31, hi = lane >> 5;
  LAS char* V_lds = lds; LAS char* K_lds = lds + 2 * SHM_V;
  LAS float* ws = (LAS float*)(lds + 65536) + wid * 64; LAS float* li_l = ws; LAS float* al_l = ws + 32;
  float m_reg = -1e30f, l_reg = 0;
#pragma unroll
  for (int d = 0; d < 4; ++d) o[d] = f32x16{};
  bf16x8 qr[ND];
  const u16* Qw = Qb + (long)(wid * 32 + r32) * ldq + hi * 8;
#pragma unroll
  for (int d0 = 0; d0 < ND; ++d0) qr[d0] = *(const bf16x8*)(Qw + d0 * 16);
  const int sr = tid >> 4, sc = (tid & 15) * 8, vst0 = v_st(sr, sc), vst1 = v_st(32 + sr, sc);
  const int ksr = (DQK == 128) ? (tid >> 4) : (tid >> 3), ksc = (DQK == 128) ? ((tid & 15) * 8) : ((tid & 7) * 8);
  const int kst0 = ksr * (DQK * 2) + ((ksc * 2) ^ ((ksr & 7) << 4)), kst1 = (32 + ksr) * (DQK * 2) + ((ksc * 2) ^ ((ksr & 7) << 4));
  const int vb0 = (int)(uintptr_t)V_lds + v_rd_base(lane);
  bf16x8 vsA0, vsA1, ksA0, ksA1, vsB0, vsB1, ksB0, ksB1;
#define SLOAD(X, k0) do { vs##X##0 = *(const bf16x8*)(Vh + (long)((k0) + sr) * ldk + sc); vs##X##1 = *(const bf16x8*)(Vh + (long)((k0) + 32 + sr) * ldk + sc); \
    ks##X##0 = *(const bf16x8*)(Kh + (long)((k0) + ksr) * ldk + ksc); if constexpr (DQK == 128) ks##X##1 = *(const bf16x8*)(Kh + (long)((k0) + 32 + ksr) * ldk + ksc); } while (0)
#define SWRITE(b, X) do { *(LAS bf16x8*)(V_lds + (b) * SHM_V + vst0) = vs##X##0; *(LAS bf16x8*)(V_lds + (b) * SHM_V + vst1) = vs##X##1; \
    *(LAS bf16x8*)(K_lds + (b) * SHM_K + kst0) = ks##X##0; if constexpr (DQK == 128) *(LAS bf16x8*)(K_lds + (b) * SHM_K + kst1) = ks##X##1; } while (0)
#define SWAIT() do { if constexpr (DQK == 128) asm volatile("s_waitcnt vmcnt(4)" ::: "memory"); else asm volatile("s_waitcnt vmcnt(3)" ::: "memory"); } while (0)
#define RESC(a) do { if (__any((a) < 1.f)) { if (hi == 0) al_l[r32] = (a); asm volatile("s_waitcnt lgkmcnt(0)" ::: "memory"); \
    _Pragma("unroll") for (int d = 0; d < 4; ++d) _Pragma("unroll") for (int r = 0; r < 16; ++r) o[d][r] *= al_l[crow(r, hi)]; } } while (0)
  f32x16 pA0, pA1, pB0, pB1; float mnA, mnB, alA, alB; bf16x8 pa0, pa1, pa2, pa3;
  SLOAD(A, 0); asm volatile("s_waitcnt vmcnt(0)" ::: "memory"); SWRITE(0, A); __syncthreads();
  qkt<DQK>(pA0, pA1, K_lds, qr, r32, hi); mask_apply<MODE>(pA0, pA1, 0, ma); partialSM<DQK>(pA0, pA1, m_reg, mnA, alA);
  SLOAD(B, 64); if (2 < NT) SLOAD(A, 128);
  SWAIT(); SWRITE(1, B); __syncthreads();
  for (int j = 1; j + 1 < NT; j += 2) {
    SBAR(); qkt<DQK>(pB0, pB1, K_lds + SHM_K, qr, r32, hi);
    finishSM(pA0, pA1, alA, l_reg, pa0, pa1, pa2, pa3); SBAR();
    SLOAD(B, (j + 2) * 64); SBAR();
    pv_d0(o, vb0, pa0, pa1, pa2, pa3); mask_apply<MODE>(pB0, pB1, j, ma); partialSM<DQK>(pB0, pB1, m_reg, mnB, alB);
    __syncthreads(); SWAIT(); SWRITE(0, A);
    RESC(alB); __syncthreads();
    SBAR(); qkt<DQK>(pA0, pA1, K_lds, qr, r32, hi);
    finishSM(pB0, pB1, alB, l_reg, pa0, pa1, pa2, pa3); SBAR();
    if (j + 3 < NT) SLOAD(A, (j + 3) * 64); SBAR();
    pv_d0(o, vb0 + SHM_V, pa0, pa1, pa2, pa3); mask_apply<MODE>(pA0, pA1, j + 1, ma); partialSM<DQK>(pA0, pA1, m_reg, mnA, alA);
    __syncthreads(); SWAIT(); SWRITE(1, B);
    RESC(alA); __syncthreads();
  }
  SBAR(); qkt<DQK>(pB0, pB1, K_lds + SHM_K, qr, r32, hi);
  finishSM(pA0, pA1, alA, l_reg, pa0, pa1, pa2, pa3); SBAR();
  pv_d0(o, vb0, pa0, pa1, pa2, pa3); mask_apply<MODE>(pB0, pB1, NT - 1, ma); partialSM<DQK>(pB0, pB1, m_reg, mnB, alB);
  __syncthreads(); RESC(alB);
  finishSM(pB0, pB1, alB, l_reg, pa0, pa1, pa2, pa3); SBAR();
  pv_d0(o, vb0 + SHM_V, pa0, pa1, pa2, pa3);
  if (hi == 0) li_l[r32] = l_reg; asm volatile("s_waitcnt lgkmcnt(0)" ::: "memory");
#pragma unroll
  for (int r = 0; r < 16; ++r) { const float rl = __builtin_amdgcn_rcpf(li_l[crow(r, hi)]);
#pragma unroll
    for (int d = 0; d < 4; ++d) o[d][r] *= rl; }
  lse_out = m_reg * SCALE + __logf(l_reg);
  __syncthreads();
#undef SLOAD
#undef SWRITE
#undef SWAIT
#undef RESC
}

DI void stage_o(LAS char* lds, const f32x16 (&o)[4], int wid, int r32, int hi) {
  LAS float* R = (LAS float*)(lds + wid * 16384) + (4 * hi) * 128 + r32;
#pragma unroll
  for (int d = 0; d < 4; ++d)
#pragma unroll
    for (int r = 0; r < 16; ++r) R[((r & 3) + 8 * (r >> 2)) * 128 + d * 32] = o[d][r];
}
DI void read_o(LAS char* lds, int wid, int row, int c8, float (&v)[8]) {
  LAS const float* R = (LAS const float*)(lds + wid * 16384) + row * 128 + c8;
  const f32x4 a = *(LAS const f32x4*)R, b = *(LAS const f32x4*)(R + 4);
  v[0] = a[0]; v[1] = a[1]; v[2] = a[2]; v[3] = a[3]; v[4] = b[0]; v[5] = b[1]; v[6] = b[2]; v[7] = b[3];
}

DI void epi_gated(const Params& p, LAS char* lds, const f32x16 (&o)[4], long q0, int zcol, int ycol) {
  const int tid = otid(), wid = tid >> 6, lane = tid & 63, r32 = lane & 31, hi = lane >> 5;
  stage_o(lds, o, wid, r32, hi);
  const int c8 = (lane & 15) * 8;
  u32x4 zr[8];
#pragma unroll
  for (int ps = 0; ps < 8; ++ps) zr[ps] = *(const u32x4*)(p.hb() + (q0 + wid * 32 + ps * 4 + (lane >> 4)) * DIN + zcol + c8);
  __builtin_amdgcn_sched_barrier(0);
#pragma unroll
  for (int ps = 0; ps < 8; ++ps) {
    const int row = ps * 4 + (lane >> 4); const long t = q0 + wid * 32 + row;
    float v[8], z[8]; read_o(lds, wid, row, c8, v);
    unpack8(zr[ps], z);
#pragma unroll
    for (int i = 0; i < 8; ++i) v[i] *= z[i];
    *(u32x4*)(p.ys() + t * DM + ycol + c8) = pack8(v);
  }
  __syncthreads();
}

DI void item_A(const Params& p, int l, int h, int qb, LAS char* lds) {
  const long q0 = (long)qb * 256;
  {
    MaskArgs ma{}; f32x16 o[4]; float lse;
    attn_body<64, 0>(p.hb() + q0 * DIN + C_AQ + h * 128, DIN, p.hb() + C_AK + h * 128, p.hb() + C_AV + h * 128, DIN, S / 64, lds, ma, o, lse);
    const int tid = otid(), wid = tid >> 6, lane = tid & 63, r32 = lane & 31, hi = lane >> 5, c8 = (lane & 15) * 8;
    float* st = p.stash() + ((long)blockIdx.x * 256 + wid * 32) * 128 + c8;
    stage_o(lds, o, wid, r32, hi);
#pragma unroll 2
    for (int ps = 0; ps < 8; ++ps) {
      const int row = ps * 4 + (lane >> 4);
      LAS const float* R = (LAS const float*)(lds + wid * 16384) + row * 128 + c8;
      *(f32x4*)(st + row * 128) = *(LAS const f32x4*)R; *(f32x4*)(st + row * 128 + 4) = *(LAS const f32x4*)(R + 4);
    }
    __syncthreads();
  }
  {
    MaskArgs ma{}; f32x16 o[4]; float lse;
    attn_body<64, 0>(p.hb() + q0 * DIN + C_AQ + h * 128 + 64, DIN, p.hb() + C_AK + h * 128 + 64, p.hb() + C_AV + h * 128, DIN, S / 64, lds, ma, o, lse);
    const int tid = otid(), wid = tid >> 6, lane = tid & 63, r32 = lane & 31, hi = lane >> 5;
    stage_o(lds, o, wid, r32, hi);
  }
  const int tid = otid(), wid = tid >> 6, lane = tid & 63, c8 = (lane & 15) * 8;
  const float* lp = p.lam + l * 256;
  float e1 = lp[lane] * lp[64 + lane], e2 = lp[128 + lane] * lp[192 + lane];
  e1 = wave_sum(e1); e2 = wave_sum(e2);
  int lo = l; asm volatile("" : "+s"(lo));
  float c08 = 0.8f; asm volatile("" : "+v"(c08));
  const float lam_init = c08 - 0.6f * expf(-0.3f * (float)lo);
  const float lam = expf(e1) - expf(e2) + lam_init;
  const float* st = p.stash() + ((long)blockIdx.x * 256 + wid * 32) * 128 + c8;
  const float* sg = p.subln_g + l * 128 + c8;
  const f32x4 g0 = *(const f32x4*)sg, g1 = *(const f32x4*)(sg + 4);
  const float gs[8] = {g0[0], g0[1], g0[2], g0[3], g1[0], g1[1], g1[2], g1[3]};
#pragma unroll
  for (int hf = 0; hf < 2; ++hf) {
    u32x4 zr[4]; f32x4 sa[4][2];
#pragma unroll
    for (int q = 0; q < 4; ++q) {
      const int row = (hf * 4 + q) * 4 + (lane >> 4);
      zr[q] = *(const u32x4*)(p.hb() + (q0 + wid * 32 + row) * DIN + C_AZ + h * 128 + c8);
      sa[q][0] = *(const f32x4*)(st + row * 128); sa[q][1] = *(const f32x4*)(st + row * 128 + 4);
    }
    __builtin_amdgcn_sched_barrier(0);
#pragma unroll
    for (int q = 0; q < 4; ++q) {
      const int row = (hf * 4 + q) * 4 + (lane >> 4); const long t = q0 + wid * 32 + row;
      float v[8], z[8]; read_o(lds, wid, row, c8, v);
      const f32x4 a0 = sa[q][0], a1 = sa[q][1];
      const float o1[8] = {a0[0], a0[1], a0[2], a0[3], a1[0], a1[1], a1[2], a1[3]};
      float ss = 0.f;
#pragma unroll
      for (int i = 0; i < 8; ++i) { v[i] = o1[i] - lam * v[i]; ss += v[i] * v[i]; }
      ss = sum16(ss);
      const float sc = rsqrtf(ss * (1.f / 128.f) + 1e-6f) * (1.f - lam_init);
      unpack8(zr[q], z);
#pragma unroll
      for (int i = 0; i < 8; ++i) v[i] = v[i] * sc * gs[i] * z[i];
      *(u32x4*)(p.ys() + t * DM + h * 128 + c8) = pack8(v);
    }
    __builtin_amdgcn_sched_barrier(0);
  }
  __syncthreads();
}
DI void item_C(const Params& p, int qh, int qb, LAS char* lds) {
  MaskArgs ma{}; f32x16 o[4]; float lse;
  const long q0 = (long)qb * 256; const int kv = qh >> 1;
  attn_body<128, 0>(p.hb() + q0 * DIN + C_CQ + qh * 128, DIN, p.hb() + C_CK + kv * 128, p.hb() + C_CV + kv * 128, DIN, S / 64, lds, ma, o, lse);
  epi_gated(p, lds, o, q0, C_CZ + qh * 128, 1024 + qh * 128);
}
DI void item_B(const Params& p, int l, int h, int g, LAS char* lds) {
  const int tid = otid(), wid = tid >> 6, lane = tid & 63, r32 = lane & 31, hi = lane >> 5;
  LAS float* tbl = (LAS float*)(lds + 65536 + 2048);
  const float* rp = p.rpb + ((long)l * 4 + h) * 465;
  for (int i = tid; i < 561; i += NTHR) { const int k = i - 48; tbl[i] = (k >= 0 && k < 465) ? rp[k] * 11.313708498984761f : 0.f; }
  __syncthreads();
  int rb = 4 * g - 4; rb = rb < 0 ? 0 : (rb > 116 ? 116 : rb);
  const int rq = __builtin_amdgcn_readfirstlane(4 * g + (wid >> 1)), cq = (wid & 1) * 32 + r32;
  int r0 = rq - 4; r0 = r0 < 0 ? 0 : (r0 > 120 ? 120 : r0);
  int c0 = cq - 8; c0 = c0 < 0 ? 0 : (c0 > 48 ? 48 : c0);
  MaskArgs ma{}; ma.u0 = rb; ma.u1 = r0; ma.u2 = rq; ma.v0 = 63 - cq + 4 * hi; ma.v1 = 4 * hi - c0; ma.tbl = tbl;
  f32x16 o[4]; float lse;
  const long q0 = (long)g * 256;
  attn_body<128, 1>(p.hb() + q0 * DIN + C_BQ + h * 128, DIN, p.hb() + (long)rb * 64 * DIN + C_BK + h * 128, p.hb() + (long)rb * 64 * DIN + C_BV + h * 128, DIN, 12, lds, ma, o, lse);
  epi_gated(p, lds, o, q0, C_BZ + h * 128, 512 + h * 128);
}
DI void item_D(const Params& p, int idx, LAS char* lds) {
  const int tid = otid(), wid = tid >> 6, lane = tid & 63, r32 = lane & 31, hi = lane >> 5;
  const int grp = idx >> 7, rem = idx & 127, hd = rem >> 5, vb = rem & 31;
  const int rate = (grp == 0) ? 1 : (grp == 1 ? 4 : 16);
  const int L = S / rate, bpc = L / 256;
  const int rho = vb / bpc, qbi = vb % bpc, q0 = qbi * 256;
  int kb = q0 - 64; kb = kb < 0 ? 0 : (kb > L - 384 ? L - 384 : kb);
  MaskArgs ma{}; ma.v0 = kb - (q0 + wid * 32 + r32) + 4 * hi + 64;
  f32x16 o[4]; float lse;
  const int head = grp * 4 + hd;
  const long ld = (long)rate * DIN;
  attn_body<128, 2>(p.hb() + (long)(rho + rate * q0) * DIN + C_DQ + head * 128, ld, p.hb() + (long)(rho + rate * kb) * DIN + C_DK + head * 128,
                    p.hb() + (long)(rho + rate * kb) * DIN + C_DV + head * 128, ld, 6, lds, ma, o, lse);
  if (hi == 0) { const long t = rho + (long)rate * (q0 + wid * 32 + r32); p.lse()[((long)grp * S + t) * 4 + hd] = lse; }
  stage_o(lds, o, wid, r32, hi);
  u16* odg = p.od() + (long)grp * S * 512 + hd * 128;
  const int c8 = (lane & 15) * 8;
#pragma unroll 2
  for (int ps = 0; ps < 8; ++ps) {
    const int row = ps * 4 + (lane >> 4); const long t = rho + (long)rate * (q0 + wid * 32 + row);
    float v[8]; read_o(lds, wid, row, c8, v);
    *(u32x4*)(odg + t * 512 + c8) = pack8(v);
  }
  __syncthreads();
}

DI void phase_attn(const Params& p, int l, LAS char* lds) {
  for (int item = blockIdx.x; item < 256; item += gridDim.x) {
    const int xcd = item & 7, slot = item >> 3;
    if (slot < 16) {
      item_A(p, l, xcd >> 1, (xcd & 1) * 16 + slot, lds);
    } else {
      const int s2 = slot - 16, cidx = s2 * 8 + xcd;
      item_C(p, xcd >> 1, (xcd & 1) * 16 + s2, lds);
      item_B(p, l, cidx >> 5, cidx & 31, lds);
      if (cidx < 64) item_D(p, cidx * 3, lds);
      else { for (int k = 0; k < 3; ++k) item_D(p, cidx * 3 + k, lds); for (int k = 1; k < 3; ++k) item_D(p, (cidx - 64) * 3 + k, lds); }
      if (cidx < 64) {
        EpiH e; e.hb = p.hb(); e.bg = p.b_gate + (long)l * 4 * DM; e.kind = 2;
        gemm_tile(p.Xb(), DM, p.WinT() + (long)l * DIN * DM, DM, DM, (cidx >> 1) * 256, (72 + (cidx & 1)) * 256, e, NoHook(), lds);
      }
    }
  }
}

DI void phase_dmerge(const Params& p) {
  for (int task = blockIdx.x * NTHR + otid(); task < S * 64; task += gridDim.x * NTHR) {
    const int t = task >> 6, ch = task & 63, hd = ch >> 4, col = ch * 8;
    const float l0 = p.lse()[((long)0 * S + t) * 4 + hd], l1 = p.lse()[((long)1 * S + t) * 4 + hd], l2 = p.lse()[((long)2 * S + t) * 4 + hd];
    const float mx = fmaxf(l0, fmaxf(l1, l2));
    float w0 = __expf(l0 - mx), w1 = __expf(l1 - mx), w2 = __expf(l2 - mx);
    const float inv = 1.f / (w0 + w1 + w2); w0 *= inv; w1 *= inv; w2 *= inv;
    const u32x4 a = *(const u32x4*)(p.od() + ((long)0 * S + t) * 512 + col);
    const u32x4 b = *(const u32x4*)(p.od() + ((long)1 * S + t) * 512 + col);
    const u32x4 c = *(const u32x4*)(p.od() + ((long)2 * S + t) * 512 + col);
    const u32x4 z = *(const u32x4*)(p.hb() + (long)t * DIN + C_DZ + col);
    u32x4 r;
#pragma unroll
    for (int i = 0; i < 4; ++i) {
      const float lo = (w0 * bflo(a[i]) + w1 * bflo(b[i]) + w2 * bflo(c[i])) * bflo(z[i]);
      const float hh = (w0 * bfhi(a[i]) + w1 * bfhi(b[i]) + w2 * bfhi(c[i])) * bfhi(z[i]);
      r[i] = cvtpk(lo, hh);
    }
    *(u32x4*)(p.ys() + (long)t * DM + 1536 + col) = r;
  }
}


#ifndef SELFCHECK
#define SELFCHECK 0
#endif
#if SELFCHECK
constexpr int CHK_L = 1;
constexpr size_t WS_FLAG = WS_END + 1024;
template <class KT, class BI>
DI void naive_attn(const u16* hb, const u16* q, int dqk, int nkeys, KT ktok, int kcol, int vcol, BI bias, float scale, LAS float* L, int tid) {
  LAS float* sc = L; LAS float* qv = L + 8192; LAS float* red = L + 8192 + 128; LAS float* ov = red + 512;
  __syncthreads();
  if (tid < dqk) qv[tid] = bf2f(q[tid]);
  __syncthreads();
  float mx = -3e38f;
  for (int j = tid; j < nkeys; j += 512) {
    const int tk = ktok(j); float s = -3e38f;
    if (tk >= 0) { const u16* kp = hb + (long)tk * DIN + kcol; float a = 0; for (int d = 0; d < dqk; ++d) a += qv[d] * bf2f(kp[d]); s = a * scale + bias(j); }
    sc[j] = s; mx = fmaxf(mx, s);
  }
  red[tid] = mx; __syncthreads();
  for (int st = 256; st >= 1; st >>= 1) { if (tid < st) red[tid] = fmaxf(red[tid], red[tid + st]); __syncthreads(); }
  mx = red[0]; __syncthreads();
  float sm = 0;
  for (int j = tid; j < nkeys; j += 512) { const float e = (sc[j] > -1e38f) ? expf(sc[j] - mx) : 0.f; sc[j] = e; sm += e; }
  red[tid] = sm; __syncthreads();
  for (int st = 256; st >= 1; st >>= 1) { if (tid < st) red[tid] += red[tid + st]; __syncthreads(); }
  sm = red[0]; __syncthreads();
  const int col = tid & 127, part = tid >> 7; float acc = 0;
  for (int j = part; j < nkeys; j += 4) { const int tk = ktok(j); if (tk >= 0) acc += sc[j] * bf2f(hb[(long)tk * DIN + vcol + col]); }
  red[tid] = acc; __syncthreads();
  if (tid < 128) ov[tid] = (red[tid] + red[tid + 128] + red[tid + 256] + red[tid + 384]) / sm;
  if (tid == 0) ov[128] = mx + logf(sm);
  __syncthreads();
}
DI void chk_compare(const Params& p, LAS float* L, const float* ref128  , float refv, int t, int ycol, int bit, int tid) {
  LAS float* red = L + 8192 + 128;
  __syncthreads();
  red[tid] = (tid < 128) ? refv * refv : 0.f; __syncthreads();
  for (int st = 256; st >= 1; st >>= 1) { if (tid < st) red[tid] += red[tid + st]; __syncthreads(); }
  const float rms = sqrtf(red[0] * (1.f / 128.f)); __syncthreads();
  if (tid < 128) {
    const float got = bf2f(p.ys()[(long)t * DM + ycol + tid]);
    const float err = fabsf(got - refv);
    if (!(err <= 0.03f * (fabsf(refv) + rms) + 1e-6f)) atomicOr((unsigned*)(p.ws + WS_FLAG), (unsigned)bit);
  }
  __syncthreads();
}
DI void selfcheck(const Params& p, int l, LAS char* lds) {
  const int tid = threadIdx.x; LAS float* L = (LAS float*)lds; LAS float* ov = L + 8192 + 128 + 512; LAS float* keep = ov + 160;
  const u16* hb = p.hb();
  const int b = blockIdx.x, br = b & 3, hd = (b >> 2) & 3, si = b >> 4;
  for (int rep = 0; rep < 2; ++rep) {
    const int t = rep == 0 ? ((si * 523 + 17 * br + 131 * hd) & 8191) : ((si < 8) ? si * 9 : 8191 - (si - 8) * 9);
    if (br == 0) {
      const float* lp = p.lam + l * 256; float e1 = 0, e2 = 0; for (int i = 0; i < 64; ++i) { e1 += lp[i] * lp[64 + i]; e2 += lp[128 + i] * lp[192 + i]; }
      const float lam_init = 0.8f - 0.6f * expf(-0.3f * (float)l), lam = expf(e1) - expf(e2) + lam_init;
      naive_attn(hb, hb + (long)t * DIN + C_AQ + hd * 128, 64, S, [](int j) { return j; }, C_AK + hd * 128, C_AV + hd * 128, [](int) { return 0.f; }, 0.125f, L, tid);
      const float o1 = (tid < 128) ? ov[tid] : 0.f;
      naive_attn(hb, hb + (long)t * DIN + C_AQ + hd * 128 + 64, 64, S, [](int j) { return j; }, C_AK + hd * 128 + 64, C_AV + hd * 128, [](int) { return 0.f; }, 0.125f, L, tid);
      const float o = (tid < 128) ? (o1 - lam * ov[tid]) : 0.f;
      LAS float* red = L + 8192 + 128;
      __syncthreads(); red[tid] = o * o; __syncthreads();
      for (int st = 256; st >= 1; st >>= 1) { if (tid < st) red[tid] += red[tid + st]; __syncthreads(); }
      const float ms = red[0] * (1.f / 128.f); __syncthreads();
      float refv = 0.f;
      if (tid < 128) refv = o * rsqrtf(ms + 1e-6f) * p.subln_g[l * 128 + tid] * (1.f - lam_init) * bf2f(hb[(long)t * DIN + C_AZ + hd * 128 + tid]);
      chk_compare(p, L, nullptr, refv, t, hd * 128, 1, tid);
    } else if (br == 1) {
      const int r = t >> 6, c = t & 63; int r0 = r - 4; r0 = r0 < 0 ? 0 : (r0 > 120 ? 120 : r0); int c0 = c - 8; c0 = c0 < 0 ? 0 : (c0 > 48 ? 48 : c0);
      const float* rp = p.rpb + ((long)l * 4 + hd) * 465;
      naive_attn(hb, hb + (long)t * DIN + C_BQ + hd * 128, 128, 128, [=](int j) { return (r0 + (j >> 4)) * 64 + c0 + (j & 15); }, C_BK + hd * 128, C_BV + hd * 128,
                 [=](int j) { return rp[(r0 + (j >> 4) - r + 7) * 31 + (c0 + (j & 15) - c + 15)]; }, 0.088388347648318440f, L, tid);
      float refv = 0.f; if (tid < 128) refv = ov[tid] * bf2f(hb[(long)t * DIN + C_BZ + hd * 128 + tid]);
      chk_compare(p, L, nullptr, refv, t, 512 + hd * 128, 2, tid);
    } else if (br == 2) {
      const int kv = hd >> 1;
      naive_attn(hb, hb + (long)t * DIN + C_CQ + hd * 128, 128, S, [](int j) { return j; }, C_CK + kv * 128, C_CV + kv * 128, [](int) { return 0.f; }, 0.088388347648318440f, L, tid);
      float refv = 0.f; if (tid < 128) refv = ov[tid] * bf2f(hb[(long)t * DIN + C_CZ + hd * 128 + tid]);
      chk_compare(p, L, nullptr, refv, t, 1024 + hd * 128, 4, tid);
    } else {
      float og[3], lg[3];
#pragma unroll
      for (int g = 0; g < 3; ++g) {
        const int rate = g == 0 ? 1 : (g == 1 ? 4 : 16), head = g * 4 + hd;
        naive_attn(hb, hb + (long)t * DIN + C_DQ + head * 128, 128, 129, [=](int j) { const int idx = t + rate * (j - 64); return (idx >= 0 && idx < S) ? idx : -1; },
                   C_DK + head * 128, C_DV + head * 128, [](int) { return 0.f; }, 0.088388347648318440f, L, tid);
        og[g] = (tid < 128) ? ov[tid] : 0.f; lg[g] = ov[128];
      }
      const float mx = fmaxf(lg[0], fmaxf(lg[1], lg[2])); float w0 = expf(lg[0] - mx), w1 = expf(lg[1] - mx), w2 = expf(lg[2] - mx); const float inv = 1.f / (w0 + w1 + w2);
      float refv = 0.f; if (tid < 128) refv = (w0 * og[0] + w1 * og[1] + w2 * og[2]) * inv * bf2f(hb[(long)t * DIN + C_DZ + hd * 128 + tid]);
      chk_compare(p, L, nullptr, refv, t, 1536 + hd * 128, 8, tid);
    }
  }
}
#endif

#define XB_TMO      128
#define XB_XCNT(j)  (256  + 64 * (j))
#define XB_XSUB(j)  (1280 + 64 * (j))
#define XB_XGEN(j)  (2304 + 64 * (j))
#define XB_TOP      3328
#define XB_TOPGEN   3392
#define XCD_BAR_WORDS 3456
#define XB_SPIN_CAP (1u << 18)
DI unsigned xb_ld(unsigned* p)              { return __hip_atomic_load(p, __ATOMIC_RELAXED, __HIP_MEMORY_SCOPE_AGENT); }
DI unsigned xb_add(unsigned* p, unsigned v) { return __hip_atomic_fetch_add(p, v, __ATOMIC_RELAXED, __HIP_MEMORY_SCOPE_AGENT); }
DI unsigned xb_xcc_id() { return (unsigned)__builtin_amdgcn_s_getreg((3 << 11) | 20) & 0xFu; }
#define XB_SPIN(cond, bar) do { unsigned _sp = 0; while (cond) { __builtin_amdgcn_s_sleep(1); \
    if ((++_sp & 255u) == 0u) { if (xb_ld(&(bar)[XB_TMO])) break; if (_sp > XB_SPIN_CAP) { atomicAdd(&(bar)[XB_TMO], 1u); break; } } } } while (0)
struct XcdBarrier { unsigned* bar; unsigned x; volatile LAS unsigned* st; };
DI XcdBarrier xcd_barrier_post(unsigned* bar, volatile LAS unsigned* st) {
  XcdBarrier b; b.bar = bar; b.x = xb_xcc_id(); b.st = st;
  if (otid() == 0) (void)xb_add(&bar[XB_XCNT(b.x)], 1u);
  return b;
}
DI void xcd_barrier_complete(unsigned* bar, unsigned x, unsigned& nloc, unsigned& nx) {
  const unsigned G = gridDim.x * gridDim.y * gridDim.z;
  unsigned sum, cnt, mine, sp = 0u;
  for (;;) {
    sum = 0u; cnt = 0u; mine = 0u;
#pragma unroll
    for (unsigned j = 0; j < 16; ++j) { const unsigned c = xb_ld(&bar[XB_XCNT(j)]); sum += c; cnt += (c > 0u) ? 1u : 0u; mine = (j == x) ? c : mine; }
    if (sum == G) break;
    __builtin_amdgcn_s_sleep(1);
    if ((++sp & 255u) == 0u) { if (xb_ld(&bar[XB_TMO])) break; if (sp > XB_SPIN_CAP) { atomicAdd(&bar[XB_TMO], 1u); break; } }
  }
  nloc = mine > 0u ? mine : 1u; nx = cnt > 0u ? cnt : 1u;
}
DI void xcd_barrier(const XcdBarrier& b) {
  asm volatile("s_waitcnt vmcnt(0)" ::: "memory");
  __syncthreads();
  if (otid() == 0) {
    unsigned* bar = b.bar;
    __builtin_amdgcn_s_waitcnt(0);
    unsigned nloc = b.st[0], nx = b.st[1];
    if (nloc == 0u) { xcd_barrier_complete(bar, b.x, nloc, nx); b.st[0] = nloc; b.st[1] = nx; }
    const unsigned old = xb_add(&bar[XB_XSUB(b.x)], 1u);
    const unsigned gen = old / nloc;
    if (old + 1u == (gen + 1u) * nloc) {
      __builtin_amdgcn_fence(__ATOMIC_RELEASE, "agent");
      asm volatile("s_waitcnt vmcnt(0)" ::: "memory");
      const unsigned og = xb_add(&bar[XB_TOP], 1u);
      const unsigned tg = og / nx;
      if (og + 1u == (tg + 1u) * nx) xb_add(&bar[XB_TOPGEN], 1u);
      else XB_SPIN(xb_ld(&bar[XB_TOPGEN]) == tg, bar);
      __builtin_amdgcn_fence(__ATOMIC_ACQUIRE, "agent");
      xb_add(&bar[XB_XGEN(b.x)], 1u);
      asm volatile("s_waitcnt vmcnt(0)" ::: "memory");
    } else {
      XB_SPIN(xb_ld(&bar[XB_XGEN(b.x)]) == gen, bar);
      __builtin_amdgcn_fence(__ATOMIC_ACQUIRE, "agent");
      asm volatile("s_waitcnt vmcnt(0)" ::: "memory");
    }
  }
  __syncthreads();
}
#ifndef REP_P0
#define REP_P0 1
#endif
#ifndef REP_G1
#define REP_G1 1
#endif
#ifndef REP_AT
#define REP_AT 1
#endif
#ifndef REP_BR
#define REP_BR 1
#endif
#ifndef REP_SM
#define REP_SM 1
#endif
__global__ void __launch_bounds__(NTHR) mega_fwd(Params p0) {
  LAS char* lds = (LAS char*)shm_;
  cg::grid_group grid = cg::this_grid();
  if ((threadIdx.x & 63) == 0) ((volatile LAS int*)(lds + 131072 + 16))[hw_slot()] = threadIdx.x >> 6;
  volatile LAS unsigned* xst = (volatile LAS unsigned*)(lds + 131072);
  if (threadIdx.x == 0) { xst[0] = 0u; xst[1] = 0u; }
  __syncthreads();
  const XcdBarrier xb = xcd_barrier_post((unsigned*)(p0.ws + WS_BAR), xst);
  for (int ph = p0.ph_lo; ph < p0.ph_hi; ++ph) {
    typedef const __attribute__((address_space(4))) Params* CParamsP;
    CParamsP pk = (CParamsP)__builtin_amdgcn_kernarg_segment_ptr();
    asm volatile("" : "+s"(pk));
    Params p;
    p.x = pk->x; p.emb_g = pk->emb_g; p.emb_b = pk->emb_b; p.w_in = pk->w_in; p.b_gate = pk->b_gate; p.lam = pk->lam; p.subln_g = pk->subln_g;
    p.rpb = pk->rpb; p.qn_g = pk->qn_g; p.kn_g = pk->kn_g; p.w_branch = pk->w_branch; p.w_out = pk->w_out; p.ln_g = pk->ln_g; p.ln_b = pk->ln_b;
    p.out = pk->out; p.ws = pk->ws; p.ph_lo = 0; p.ph_hi = 0;
    if (ph == 0) {
      for (int rep = 0; rep < REP_P0; ++rep) {
      phase_transpose(p.w_in, p.WinT(), DM, DIN, NL, lds);
      phase_transpose(p.w_branch, p.WbT(), DM, DM, NL, lds);
      phase_transpose(p.w_out, p.WoT(), DM, DM, NL, lds);
      }
      phase_ln(p.x, p.emb_g, p.emb_b, p.X(), p.Xb());
      phase_tables(p);
    } else {
      const int l = (ph - 1) / 6, sp = (ph - 1) % 6;
      if (sp == 0) {
        const int nM = S / 256, nN = DIN / 256 - 2;
        for (int rep = 0; rep < REP_G1; ++rep) {
          bool pre = false;
          for (int L = blockIdx.x; L < nM * nN; L += gridDim.x) {
            int pm, pn; tile_order(L, nM, nN, pm, pn);
            int pm2 = -1, pn2 = 0; if (L + (int)gridDim.x < nM * nN) tile_order(L + gridDim.x, nM, nN, pm2, pn2);
            EpiH e; e.hb = p.hb(); e.bg = p.b_gate + (long)l * 4 * DM;
            e.kind = (pn >= 42) ? 2 : ((pn == 6 || pn == 7 || pn == 14 || pn == 15 || pn == 20 || pn == 21 || pn == 40 || pn == 41) ? 1 : 0);
            gemm_tile(p.Xb(), DM, p.WinT() + (long)l * DIN * DM, DM, DM, pm * 256, pn * 256, e, NoHook(), lds, pre, pm2 < 0 ? -1 : pm2 * 256, pn2 * 256);
            pre = pm2 >= 0;
          }
        }
      } else if (sp == 1) {
        phase_prep(p, l);
      } else if (sp == 2) {
        for (int rep = 0; rep < REP_AT; ++rep) phase_attn(p, l, lds);
      } else if (sp == 3) {
        for (int rep = 0; rep < REP_SM; ++rep) phase_dmerge(p);
      } else if (sp == 4) {
        const int nM = S / 256, nN = DM / 256;
        for (int rep = 0; rep < REP_BR; ++rep)
        for (int L = blockIdx.x; L < nM * nN; L += gridDim.x) {
          int pm, pn; tile_order(L, nM, nN, pm, pn);
          EpiBrF e; e.hb = p.hb(); e.mb = p.mb(); GateHook gh; gh.hb = p.hb();
          gemm_tile(p.ys(), DM, p.WbT() + (long)l * DM * DM, DM, DM, pm * 256, pn * 256, e, gh, lds);
        }
      } else if (sp == 5) {
        const int nM = S / 256, nN = DM / 256;
        for (int L = blockIdx.x; L < nM * nN; L += gridDim.x) {
          int pm, pn; tile_order(L, nM, nN, pm, pn);
          EpiOutLN e; e.X = p.X(); e.Xb = p.Xb(); e.outp = p.out; e.g = p.ln_g + l * DM; e.b = p.ln_b + l * DM; e.alpha = 1.6817928305074290f;
          e.stats = (float*)(p.ws + WS_LNS) + (long)l * 32 * 8 * 256 * 2; e.cnt = (unsigned*)(p.ws + WS_LNC) + l * 32 * 64; e.last = (l == NL - 1); e.pm = pm; e.pn = pn;
          gemm_tile(p.mb(), DM, p.WoT() + (long)l * DM * DM, DM, DM, pm * 256, pn * 256, e, NoHook(), lds);
        }
      }
    }
    if (ph + 1 < p0.ph_hi) { if (p0.ph_lo < 0) grid.sync(); else xcd_barrier(xb); }
  }
}

#if SELFCHECK
__global__ void __launch_bounds__(NTHR) chk_kernel(Params p) {
  extern __shared__ __attribute__((aligned(16))) char shm2_[];
  selfcheck(p, CHK_L, (LAS char*)shm2_);
}

#ifndef CHK2_SIGN
#define CHK2_SIGN 1.f
#endif
__global__ void __launch_bounds__(NTHR) chk2_kernel(Params p) {
  extern __shared__ __attribute__((aligned(16))) char shm3_[];
  float* hraw = (float*)shm3_;
  const int tid = threadIdx.x, b = blockIdx.x, l = CHK_L;
  int t = (b < 224) ? ((b * 37 + 11) & 8191) : ((b - 224 < 16) ? (b - 224) * 5 : 8191 - (b - 240) * 5);
  const u16* xr = p.Xb() + (long)t * DM;
  for (int i = tid; i < 4864; i += NTHR) {
    const int col = i < 1024 ? i : (i < 1792 ? 4096 + (i - 1024) : 5632 + (i - 1792));
    const u16* wr = p.WinT() + ((long)l * DIN + col) * DM; float a = 0.f;
    for (int k = 0; k < DM; ++k) a += bf2f(xr[k]) * bf2f(wr[k]);
    hraw[i] = a;
  }
  __syncthreads();
  const float ft = (float)t;
  for (int i = tid; i < 4864; i += NTHR) {
    float ref; unsigned bit; int col;
    if (i < 1024) {
      const int d = i & 63, base = i & ~63; bit = 16u; col = i;
      if (d < 16) { const int dd = d & 7; const float ang = ft * powf(500000.f, -(float)dd / 8.f), cs = cosf(ang), sn = CHK2_SIGN * sinf(ang), x1 = hraw[base + dd], x2 = hraw[base + dd + 8];
        ref = d < 8 ? x1 * cs - x2 * sn : x2 * cs + x1 * sn; } else ref = hraw[i];
    } else if (i < 1792) {
      const int j = i - 1024, vec = j >> 7, d = j & 127, base = 1024 + (j & ~127); bit = 32u; col = 4096 + j;
      float ss = 0.f; for (int e = 0; e < 128; ++e) ss += hraw[base + e] * hraw[base + e];
      const float rs = rsqrtf(ss / 128.f + 1e-6f); const float* g = (vec < 4 ? p.qn_g : p.kn_g) + l * 128;
      const int seg = d >> 6, dd = d & 31, hi32 = (d >> 5) & 1; const float pos = seg ? (float)(t & 63) : (float)(t >> 6);
      const float ang = pos * powf(10000.f, -(float)dd / 32.f), cs = cosf(ang), sn = CHK2_SIGN * sinf(ang);
      const float x1 = hraw[base + seg * 64 + dd] * rs * g[seg * 64 + dd], x2 = hraw[base + seg * 64 + dd + 32] * rs * g[seg * 64 + dd + 32];
      ref = hi32 ? x2 * cs + x1 * sn : x1 * cs - x2 * sn;
    } else {
      const int j = i - 1792, d = j & 127, base = 1792 + (j & ~127); bit = 64u; col = 5632 + j;
      if (d < 32) { const int dd = d & 15; const float ang = ft * powf(500000.f, -(float)dd / 16.f), cs = cosf(ang), sn = CHK2_SIGN * sinf(ang), x1 = hraw[base + dd], x2 = hraw[base + dd + 16];
        ref = d < 16 ? x1 * cs - x2 * sn : x2 * cs + x1 * sn; } else ref = hraw[i];
    }
    const float got = bf2f(p.hb()[(long)t * DIN + col]);
    if (!(fabsf(got - ref) <= 0.02f * fabsf(ref) + 0.03f)) atomicOr((unsigned*)(p.ws + WS_FLAG), bit);
  }
}
__global__ void poison_kernel(Params p) {
  const unsigned f = *(unsigned*)(p.ws + WS_FLAG);
  if (f) p.out[0] = 1000.f * (float)f;
}
#endif
#ifndef MK_MULTI
#define MK_MULTI 0
#endif
extern "C" void kernel_launch(void* const* d_in, const int* in_sizes, int n_in, void* d_out, int out_size, void* d_ws, size_t ws_size, hipStream_t stream) {
  static int grid = 0;
  if (grid == 0) {
    if (n_in != 14 || in_sizes[0] != S * DM || out_size != S * DM || ws_size < WS_END + 4096) {
      fprintf(stderr, "kernel_launch: shape/workspace mismatch (n_in %d, in0 %d, out %d, ws %zu, need %zu)\n", n_in, n_in > 0 ? in_sizes[0] : -1, out_size, ws_size, (size_t)WS_END);
      grid = -1; return; }
    int dev = 0, cus = 0, per_cu = 0;
    hipGetDevice(&dev);
    hipDeviceGetAttribute(&cus, hipDeviceAttributeMultiprocessorCount, dev);
    if (hipFuncSetAttribute((const void*)mega_fwd, hipFuncAttributeMaxDynamicSharedMemorySize, LDS_BYTES) != hipSuccess) { fprintf(stderr, "kernel_launch: hipFuncSetAttribute failed\n"); grid = -1; return; }
    if (hipOccupancyMaxActiveBlocksPerMultiprocessor(&per_cu, (const void*)mega_fwd, NTHR, LDS_BYTES) != hipSuccess || per_cu < 1) { fprintf(stderr, "kernel_launch: occupancy query failed (%d)\n", per_cu); per_cu = 1; }
    (void)hipGetLastError();
    grid = cus * 1;
    fprintf(stderr, "kernel_launch: cus %d per_cu %d grid %d\n", cus, per_cu, grid);
  }
  if (grid < 0) return;
  Params p{};
  p.x = (const float*)d_in[0]; p.emb_g = (const float*)d_in[1]; p.emb_b = (const float*)d_in[2]; p.w_in = (const float*)d_in[3]; p.b_gate = (const float*)d_in[4];
  p.lam = (const float*)d_in[5]; p.subln_g = (const float*)d_in[6]; p.rpb = (const float*)d_in[7]; p.qn_g = (const float*)d_in[8]; p.kn_g = (const float*)d_in[9];
  p.w_branch = (const float*)d_in[10]; p.w_out = (const float*)d_in[11]; p.ln_g = (const float*)d_in[12]; p.ln_b = (const float*)d_in[13];
  p.out = (float*)d_out;
  p.ws = (char*)d_ws;
  const int NPH = 1 + 6 * NL;
#if MK_MULTI
  for (int ph = 0; ph < NPH; ++ph) {
    p.ph_lo = ph; p.ph_hi = ph + 1;
    hipLaunchKernelGGL(mega_fwd, dim3(grid), dim3(NTHR), LDS_BYTES, stream, p);
  }
#else
  (void)hipMemsetAsync(p.ws + WS_BAR, 0, 16384 + NL * 32 * 256, stream);
#if SELFCHECK
  hipMemsetAsync(p.ws + WS_FLAG, 0, 256, stream);
  { p.ph_lo = 0; p.ph_hi = 1 + 6 * CHK_L + 2; void* args[] = {&p};
    hipError_t e = hipLaunchCooperativeKernel((const void*)mega_fwd, dim3(grid), dim3(NTHR), args, LDS_BYTES, stream);
    if (e != hipSuccess) fprintf(stderr, "kernel_launch: cooperative launch failed: %s (grid %d)\n", hipGetErrorString(e), grid); }
  hipLaunchKernelGGL(chk2_kernel, dim3(256), dim3(NTHR), 32768, stream, p);
  (void)hipMemsetAsync(p.ws + WS_BAR, 0, 16384, stream);
  { p.ph_lo = 1 + 6 * CHK_L + 2; p.ph_hi = 1 + 6 * CHK_L + 4; void* args[] = {&p};
    hipError_t e = hipLaunchCooperativeKernel((const void*)mega_fwd, dim3(grid), dim3(NTHR), args, LDS_BYTES, stream);
    if (e != hipSuccess) fprintf(stderr, "kernel_launch: cooperative launch failed: %s (grid %d)\n", hipGetErrorString(e), grid); }
  hipFuncSetAttribute((const void*)chk_kernel, hipFuncAttributeMaxDynamicSharedMemorySize, 65536);
  hipLaunchKernelGGL(chk_kernel, dim3(256), dim3(NTHR), 65536, stream, p);
  (void)hipMemsetAsync(p.ws + WS_BAR, 0, 16384, stream);
  { p.ph_lo = 1 + 6 * CHK_L + 4; p.ph_hi = NPH; void* args[] = {&p};
    hipError_t e = hipLaunchCooperativeKernel((const void*)mega_fwd, dim3(grid), dim3(NTHR), args, LDS_BYTES, stream);
    if (e != hipSuccess) fprintf(stderr, "kernel_launch: cooperative launch failed: %s (grid %d)\n", hipGetErrorString(e), grid); }
  hipLaunchKernelGGL(poison_kernel, dim3(1), dim3(1), 0, stream, p);
#else
  p.ph_lo = 0; p.ph_hi = NPH;
  void* args[] = {&p};
  hipError_t e = hipLaunchCooperativeKernel((const void*)mega_fwd, dim3(grid), dim3(NTHR), args, LDS_BYTES, stream);
  if (e != hipSuccess) fprintf(stderr, "kernel_launch: cooperative launch failed: %s (grid %d)\n", hipGetErrorString(e), grid);
#endif
#endif
}
```

```cpp
#include <hip/hip_runtime.h>
#include <hip/hip_bf16.h>
#include <hip/hip_cooperative_groups.h>
#include <cstdio>
#include <cstdint>
namespace cg = cooperative_groups;

#define LAS __attribute__((address_space(3)))
#define DI __device__ __forceinline__
typedef unsigned short u16;
using bf16x8 = __attribute__((ext_vector_type(8))) short;
using s16x4  = __attribute__((ext_vector_type(4))) short;
using f32x4  = __attribute__((ext_vector_type(4))) float;
using f32x16 = __attribute__((ext_vector_type(16))) float;
using u32x4  = __attribute__((ext_vector_type(4))) unsigned;
using u32x2  = __attribute__((ext_vector_type(2))) unsigned;

constexpr int S = 8192, DM = 2048, DIN = 18944, NL = 4;
constexpr int C_AQ = 0, C_AK = 512, C_AV = 1024, C_AZ = 1536, C_BQ = 2048, C_BK = 2560, C_BV = 3072, C_BZ = 3584,
              C_CQ = 4096, C_CK = 4608, C_CV = 4864, C_CZ = 5120, C_DQ = 5632, C_DK = 7168, C_DV = 8704, C_DZ = 10240, C_GL = 10752;
constexpr int NTHR = 512;
constexpr int LDS_BYTES = 131072 + 16 + 256;

constexpr size_t WS_WIN = 0;
constexpr size_t WS_WB  = WS_WIN + (size_t)NL * DIN * DM * 2;
constexpr size_t WS_WO  = WS_WB + (size_t)NL * 4 * DM * 512 * 2;
constexpr size_t WS_X   = WS_WO + (size_t)NL * DM * DM * 2;
constexpr size_t WS_XB  = WS_X + (size_t)S * DM * 4;
constexpr size_t WS_H   = WS_XB + (size_t)S * DM * 2;
constexpr size_t WS_YS  = WS_H + (size_t)S * DIN * 2;
constexpr size_t WS_OD  = WS_YS + (size_t)S * DM * 2;
constexpr size_t WS_LSE = WS_OD + (size_t)3 * S * 512 * 2;
constexpr size_t WS_MACC = WS_LSE + (size_t)3 * S * 4 * 4;
constexpr size_t WS_MB  = WS_MACC + (size_t)S * DM * 4;
constexpr size_t WS_STASH = WS_MB + (size_t)S * DM * 2;
constexpr size_t WS_TA = WS_STASH + (size_t)256 * 64 * 512 * 4;
constexpr size_t WS_TD = WS_TA + (size_t)S * 8 * 2 * 4;
constexpr size_t WS_TC = WS_TD + (size_t)S * 16 * 2 * 4;
constexpr size_t WS_BAR = WS_TC + (size_t)128 * 32 * 2 * 4;
constexpr size_t WS_LNC = WS_BAR + 16384;
constexpr size_t WS_LNS = WS_LNC + (size_t)NL * 32 * 256;
constexpr size_t WS_END = WS_LNS + (size_t)NL * 32 * 8 * 256 * 2 * 4;

struct Params {
  const float* x; const float* emb_g; const float* emb_b; const float* w_in; const float* b_gate; const float* lam; const float* subln_g;
  const float* rpb; const float* qn_g; const float* kn_g; const float* w_branch; const float* w_out; const float* ln_g; const float* ln_b;
  float* out; char* ws;
  int ph_lo, ph_hi;
  DI u16* WinT() const { return (u16*)(ws + WS_WIN); }
  DI u16* WbT() const { return (u16*)(ws + WS_WB); }
  DI u16* WoT() const { return (u16*)(ws + WS_WO); }
  DI float* X() const { return (float*)(ws + WS_X); }
  DI u16* Xb() const { return (u16*)(ws + WS_XB); }
  DI u16* hb() const { return (u16*)(ws + WS_H); }
  DI u16* ys() const { return (u16*)(ws + WS_YS); }
  DI u16* od() const { return (u16*)(ws + WS_OD); }
  DI float* lse() const { return (float*)(ws + WS_LSE); }
  DI float* macc() const { return (float*)(ws + WS_MACC); }
  DI u16* mb() const { return (u16*)(ws + WS_MB); }
  DI float* stash() const { return (float*)(ws + WS_STASH); }
  DI float* tA() const { return (float*)(ws + WS_TA); }
  DI float* tD() const { return (float*)(ws + WS_TD); }
  DI float* tC() const { return (float*)(ws + WS_TC); }
};

extern __shared__ __attribute__((aligned(16))) char shm_[];
DI int hw_slot() { return (int)(__builtin_amdgcn_s_getreg((5 << 11) | 4) & 63u); }
DI int otid() {
  volatile LAS int* wtab = (volatile LAS int*)((LAS char*)shm_ + 131072 + 16);
  const int wv = __builtin_amdgcn_readfirstlane(wtab[hw_slot()]) & 7;
  int t = wv * 64 + (int)__builtin_amdgcn_mbcnt_hi(~0u, __builtin_amdgcn_mbcnt_lo(~0u, 0u));
  asm volatile("" : "+v"(t));
  return t & 511;
}
DI unsigned cvtpk(float lo, float hi) { unsigned r; asm volatile("v_cvt_pk_bf16_f32 %0, %1, %2" : "=v"(r) : "v"(lo), "v"(hi)); return r; }
DI float bf2f(u16 v) { return __uint_as_float(((unsigned)v) << 16); }
DI float bflo(unsigned w) { return __uint_as_float(w << 16); }
DI float bfhi(unsigned w) { return __uint_as_float(w & 0xffff0000u); }
DI u16 f2bf(float x) { return (u16)(cvtpk(x, x) & 0xffffu); }
DI float sigmoidf_(float x) { return __builtin_amdgcn_rcpf(1.f + __expf(-x)); }
DI float siluf_(float x) { return x * sigmoidf_(x); }
DI u32x4 pack8(const float (&v)[8]) { u32x4 w = {cvtpk(v[0], v[1]), cvtpk(v[2], v[3]), cvtpk(v[4], v[5]), cvtpk(v[6], v[7])}; return w; }
DI void unpack8(u32x4 w, float (&v)[8]) { v[0] = bflo(w[0]); v[1] = bfhi(w[0]); v[2] = bflo(w[1]); v[3] = bfhi(w[1]); v[4] = bflo(w[2]); v[5] = bfhi(w[2]); v[6] = bflo(w[3]); v[7] = bfhi(w[3]); }

DI void phase_transpose(const float* __restrict__ src, u16* __restrict__ dst, int K, int N, int nmat, LAS char* lds) {
  const int tid = otid();
  const int tk = K / 128, tn = N / 64; const int per = tk * tn; const long ntiles = (long)nmat * per;
  LAS unsigned* T = (LAS unsigned*)lds;
  for (long t = blockIdx.x; t < ntiles; t += gridDim.x) {
    const int mat = (int)(t / per), rem = (int)(t % per), kt = rem / tn, nt_ = rem % tn;
    const float* s = src + ((long)mat * K + kt * 128) * N + nt_ * 64;
#pragma unroll
    for (int i = 0; i < 2; ++i) {
      const int idx = tid + i * 512, kp = idx >> 4, c4 = idx & 15;
      const float4 a = *(const float4*)(s + (long)(2 * kp) * N + c4 * 4);
      const float4 b = *(const float4*)(s + (long)(2 * kp + 1) * N + c4 * 4);
      T[(c4 * 4 + 0) * 68 + kp] = cvtpk(a.x, b.x);
      T[(c4 * 4 + 1) * 68 + kp] = cvtpk(a.y, b.y);
      T[(c4 * 4 + 2) * 68 + kp] = cvtpk(a.z, b.z);
      T[(c4 * 4 + 3) * 68 + kp] = cvtpk(a.w, b.w);
    }
    __syncthreads();
    u16* d = dst + ((long)mat * N + nt_ * 64) * K + kt * 128;
#pragma unroll
    for (int i = 0; i < 2; ++i) {
      const int idx = tid + i * 512, nr = idx >> 4, ch = idx & 15;
      const u32x4 v = *(LAS const u32x4*)(T + nr * 68 + ch * 4);
      *(u32x4*)(d + (long)nr * K + ch * 8) = v;
    }
    __syncthreads();
  }
}

template <int M> DI float shx(float v) { return __int_as_float(__builtin_amdgcn_ds_swizzle(__float_as_int(v), (M << 10) | 0x1f)); }
DI float sum16(float v) { v += shx<8>(v); v += shx<4>(v); v += shx<2>(v); v += shx<1>(v); return v; }
DI float sum32(float v) { v += shx<16>(v); return sum16(v); }
DI float wave_sum(float v) {
  v = sum32(v);
  auto rr = __builtin_amdgcn_permlane32_swap(__float_as_uint(v), __float_as_uint(v), false, false);
  return __uint_as_float(rr[0]) + __uint_as_float(rr[1]);
}
DI void phase_ln(const float* __restrict__ src, const float* __restrict__ g, const float* __restrict__ b, float* __restrict__ dstf, u16* __restrict__ dstb) {
  const int tid = otid(), wid = tid >> 6, lane = tid & 63;
  for (int row = blockIdx.x * 8 + wid; row < S; row += gridDim.x * 8) {
    const float* sr = src + (long)row * DM;
    float4 v[8]; float sum = 0.f;
#pragma unroll
    for (int j = 0; j < 8; ++j) { v[j] = *(const float4*)(sr + (j * 64 + lane) * 4); sum += v[j].x + v[j].y + v[j].z + v[j].w; }
    const float mu = wave_sum(sum) * (1.f / DM);
    float sq = 0.f;
#pragma unroll
    for (int j = 0; j < 8; ++j) { v[j].x -= mu; v[j].y -= mu; v[j].z -= mu; v[j].w -= mu; sq += v[j].x * v[j].x + v[j].y * v[j].y + v[j].z * v[j].z + v[j].w * v[j].w; }
    const float rs = rsqrtf(wave_sum(sq) * (1.f / DM) + 1e-5f);
#pragma unroll
    for (int j = 0; j < 8; ++j) {
      const int c = (j * 64 + lane) * 4;
      const float4 gg = *(const float4*)(g + c), bb = *(const float4*)(b + c);
      float4 y; y.x = v[j].x * rs * gg.x + bb.x; y.y = v[j].y * rs * gg.y + bb.y; y.z = v[j].z * rs * gg.z + bb.z; y.w = v[j].w * rs * gg.w + bb.w;
      *(float4*)(dstf + (long)row * DM + c) = y;
      if (dstb) { u32x2 w = {cvtpk(y.x, y.y), cvtpk(y.z, y.w)}; *(u32x2*)(dstb + (long)row * DM + c) = w; }
    }
  }
}

DI int lds_byte(int r, int c) { int st = (r >> 4) * 2 + (c >> 5), rr = r & 15, cc = c & 31, ob = rr * 64 + cc * 2; return st * 1024 + (ob ^ (((ob >> 9) & 1) << 5)); }
DI void stage_rc(int b, int& R, int& C) { int st = b / 1024, sb = b % 1024, swz = sb ^ (((sb >> 9) & 1) << 5); R = (st >> 1) * 16 + swz / 64; C = (st & 1) * 32 + (swz % 64) / 2; }

DI void tile_order(int L, int nM, int nN, int& pm, int& pn) {
  const int nwg = nM * nN; int wgid = L;
  { const int q = nwg / 8, r = nwg % 8, xcd = wgid % 8, off = wgid / 8; wgid = (xcd < r ? xcd * (q + 1) : r * (q + 1) + (xcd - r) * q) + off; }
  const int nig = 8 * nN, gid = wgid / nig, fm = gid * 8, gsz = (nM - fm) < 8 ? (nM - fm) : 8;
  pm = fm + ((wgid % nig) % gsz); pn = (wgid % nig) / gsz;
}

struct NoHook { DI void operator()(int, f32x4 (&)[2][2][4][2], int, int, int, int, int, int) const {} };
template <class Epi, class Hook>
DI void gemm_tile(const u16* __restrict__ A, int lda, const u16* __restrict__ Bt, int ldb, int K, int brow, int bcol, const Epi& epi, const Hook& hook, LAS char* shm,
               bool pre = false, int nbrow = -1, int nbcol = 0) {
  const int tid = otid();
  int R0, C0, R1, C1; stage_rc(tid * 16, R0, C0); stage_rc(tid * 16 + 8192, R1, C1);
  const int R0b = (R0 & ~31) + 8 * ((R0 & 15) >> 2) + 4 * ((R0 >> 4) & 1) + (R0 & 3), R1b = (R1 & ~31) + 8 * ((R1 & 15) >> 2) + 4 * ((R1 >> 4) & 1) + (R1 & 3);
  const unsigned oa0 = (unsigned)(R0 * lda + C0) * 2u, oa1 = (unsigned)(R1 * lda + C1) * 2u, ob0 = (unsigned)(R0b * ldb + C0) * 2u, ob1 = (unsigned)(R1b * ldb + C1) * 2u;
#define SA(b, h) (shm + ((b) * 2 + (h)) * 16384)
#define SB(b, h) (shm + (4 + (b) * 2 + (h)) * 16384)
#define STAGE_A(P, br, kt) do { const char* _g = (const char*)(A + (long)(br) * lda + (long)(kt) * 64); \
    __builtin_amdgcn_global_load_lds((const unsigned*)(_g + oa0), (LAS unsigned*)((P) + tid * 16), 16, 0, 0); \
    __builtin_amdgcn_global_load_lds((const unsigned*)(_g + oa1), (LAS unsigned*)((P) + tid * 16 + 8192), 16, 0, 0); } while (0)
#define STAGE_B(P, bc, kt) do { const char* _g = (const char*)(Bt + (long)(bc) * ldb + (long)(kt) * 64); \
    __builtin_amdgcn_global_load_lds((const unsigned*)(_g + ob0), (LAS unsigned*)((P) + tid * 16), 16, 0, 0); \
    __builtin_amdgcn_global_load_lds((const unsigned*)(_g + ob1), (LAS unsigned*)((P) + tid * 16 + 8192), 16, 0, 0); } while (0)
#define LDA(dst, b, h) _Pragma("unroll") for (int m = 0; m < 4; ++m) _Pragma("unroll") for (int k = 0; k < 2; ++k) \
    dst[m][k] = *(LAS const bf16x8*)(SA(b, h) + aoff + m * 2048 + k * 1024)
#define LDB(dst, b, h) _Pragma("unroll") for (int n = 0; n < 2; ++n) _Pragma("unroll") for (int k = 0; k < 2; ++k) \
    dst[n][k] = *(LAS const bf16x8*)(SB(b, h) + boff + n * 2048 + k * 1024)
#define MMA(ai, bj, At_, Bt_) do { __builtin_amdgcn_s_setprio(1); \
    _Pragma("unroll") for (int m = 0; m < 4; ++m) _Pragma("unroll") for (int n = 0; n < 2; ++n) _Pragma("unroll") for (int k = 0; k < 2; ++k) \
      acc[ai][bj][m][n] = __builtin_amdgcn_mfma_f32_16x16x32_bf16(Bt_[n][k], At_[m][k], acc[ai][bj][m][n], 0, 0, 0); \
    __builtin_amdgcn_s_setprio(0); } while (0)
#define WAIT_V(n) asm volatile("s_waitcnt vmcnt(" #n ")" ::: "memory")
#define WAIT_L(n) asm volatile("s_waitcnt lgkmcnt(" #n ")" ::: "memory")
#define BAR __builtin_amdgcn_s_barrier()
#define SCHED __builtin_amdgcn_sched_barrier(0)
  const int wid = tid >> 6, lane = tid & 63, wr = wid >> 2, wc = wid & 3, fr = lane & 15, fq = lane >> 4;
  const int fsw = lds_byte(fr, fq * 8), aoff = wr * 8192 + fsw, boff = wc * 4096 + fsw;
  f32x4 acc[2][2][4][2] = {};
  bf16x8 At[4][2], B0[2][2], B1[2][2];
  const int nt = K / 64;
  if (!pre) {
    STAGE_B(SB(0, 0), bcol, 0); STAGE_A(SA(0, 0), brow, 0);
    STAGE_B(SB(0, 1), bcol + 128, 0); STAGE_A(SA(0, 1), brow + 128, 0);
  }
  if (wr == 1) BAR;
  WAIT_V(4); BAR;
  STAGE_B(SB(1, 0), bcol, 1); STAGE_A(SA(1, 0), brow, 1); STAGE_B(SB(1, 1), bcol + 128, 1);
  WAIT_V(6); BAR;
#pragma unroll 1
  for (int t = 0; t < nt - 2; t += 2) {
    hook(t, acc, brow, bcol, wr, wc, fr, fq);
    LDB(B0, 0, 0); SCHED; LDA(At, 0, 0); STAGE_A(SA(1, 1), brow + 128, t + 1);
    WAIT_L(8); BAR; WAIT_L(0); MMA(0, 0, At, B0); BAR; SCHED;
    LDB(B1, 0, 1); STAGE_B(SB(0, 0), bcol, t + 2);
    BAR; WAIT_L(0); MMA(0, 1, At, B1); BAR;
    LDA(At, 0, 1); STAGE_A(SA(0, 0), brow, t + 2);
    BAR; WAIT_L(0); MMA(1, 0, At, B0); BAR; SCHED;
    STAGE_B(SB(0, 1), bcol + 128, t + 2);
    WAIT_V(6); BAR; MMA(1, 1, At, B1); BAR;
    LDB(B0, 1, 0); SCHED; LDA(At, 1, 0); STAGE_A(SA(0, 1), brow + 128, t + 2);
    WAIT_L(8); BAR; WAIT_L(0); MMA(0, 0, At, B0); BAR; SCHED;
    LDB(B1, 1, 1); STAGE_B(SB(1, 0), bcol, t + 3);
    BAR; WAIT_L(0); MMA(0, 1, At, B1); BAR;
    LDA(At, 1, 1); STAGE_A(SA(1, 0), brow, t + 3);
    BAR; WAIT_L(0); MMA(1, 0, At, B0); BAR; SCHED;
    STAGE_B(SB(1, 1), bcol + 128, t + 3);
    WAIT_V(6); BAR; MMA(1, 1, At, B1); BAR;
  }
  { LDB(B0, 0, 0); LDA(At, 0, 0); STAGE_A(SA(1, 1), brow + 128, nt - 1);
    BAR; WAIT_L(0); MMA(0, 0, At, B0); BAR;
    LDB(B1, 0, 1); BAR; WAIT_L(0); MMA(0, 1, At, B1); BAR;
    LDA(At, 0, 1); WAIT_V(4); BAR; WAIT_L(0); MMA(1, 0, At, B0); MMA(1, 1, At, B1); BAR; }
  { LDB(B0, 1, 0); LDA(At, 1, 0); WAIT_V(2); BAR; WAIT_L(0); MMA(0, 0, At, B0); BAR;
    LDB(B1, 1, 1); WAIT_V(0); BAR; WAIT_L(0); MMA(0, 1, At, B1); BAR;
    LDA(At, 1, 1); BAR; WAIT_L(0); MMA(1, 0, At, B0); MMA(1, 1, At, B1); BAR; }
  if (wr == 0) BAR;
  if (nbrow >= 0) {
    STAGE_B(SB(0, 0), nbcol, 0); STAGE_A(SA(0, 0), nbrow, 0);
    STAGE_B(SB(0, 1), nbcol + 128, 0); STAGE_A(SA(0, 1), nbrow + 128, 0);
  }
  if constexpr (Epi::TILE) { epi.tile(acc, brow, bcol, wr, wc, fr, fq, shm); } else {
#pragma unroll
  for (int ai = 0; ai < 2; ++ai)
#pragma unroll
    for (int m = 0; m < 4; ++m) {
#pragma unroll
      for (int bj = 0; bj < 2; ++bj)
        epi(brow + ai * 128 + wr * 64 + m * 16 + fr, bcol + bj * 128 + wc * 32 + fq * 8, acc[ai][bj][m][0], acc[ai][bj][m][1]);
      if (((ai * 4 + m) % Epi::GRP) == Epi::GRP - 1) SCHED;
    }
  }
  asm volatile("s_waitcnt vmcnt(0)" ::: "memory");
  __syncthreads();
#undef SA
#undef SB
#undef STAGE_A
#undef STAGE_B
#undef LDA
#undef LDB
#undef MMA
}

DI void unpack8f(u32x4 w, f32x4& a, f32x4& b) { a[0] = bflo(w[0]); a[1] = bfhi(w[0]); a[2] = bflo(w[1]); a[3] = bfhi(w[1]); b[0] = bflo(w[2]); b[1] = bfhi(w[2]); b[2] = bflo(w[3]); b[3] = bfhi(w[3]); }
struct EpiH {
  static constexpr bool TILE = false; static constexpr int GRP = 1;
  u16* hb; const float* bg; int kind;
  DI void operator()(int row, int col, f32x4 v0, f32x4 v1) const {
    if (kind == 2) {
      const f32x4 b0 = *(const f32x4*)(bg + (col - C_GL)), b1 = *(const f32x4*)(bg + (col - C_GL) + 4);
#pragma unroll
      for (int j = 0; j < 4; ++j) { v0[j] = sigmoidf_(v0[j] + b0[j]); v1[j] = sigmoidf_(v1[j] + b1[j]); }
    } else if (kind == 1) {
#pragma unroll
      for (int j = 0; j < 4; ++j) { v0[j] = siluf_(v0[j]); v1[j] = siluf_(v1[j]); }
    }
    u32x4 w = {cvtpk(v0[0], v0[1]), cvtpk(v0[2], v0[3]), cvtpk(v1[0], v1[1]), cvtpk(v1[2], v1[3])};
    *(u32x4*)(hb + (long)row * DIN + col) = w;
  }
};
#ifndef HGRP
#define HGRP 4
#endif
struct GateHook {
  const u16* hb;
  DI void operator()(int t, f32x4 (&acc)[2][2][4][2], int brow, int bcol, int wr, int wc, int fr, int fq) const {
    if (t == 8 || t == 16 || t == 24) {
      const int n = (t >> 3) - 1;
      int fr_ = fr; asm volatile("" : "+v"(fr_));
      const u16* gp = hb + (long)(brow + wr * 64 + fr_) * DIN + C_GL + n * DM + bcol + wc * 32 + fq * 8;
#pragma unroll
      for (int ai = 0; ai < 2; ++ai)
#pragma unroll
        for (int mh = 0; mh < 4; mh += HGRP) {
          u32x4 wa[HGRP][2], wb[HGRP][2];
#pragma unroll
          for (int q = 0; q < HGRP; ++q) {
            const u16* rp = gp + (long)(ai * 128 + (mh + q) * 16) * DIN;
#pragma unroll
            for (int bj = 0; bj < 2; ++bj) { wa[q][bj] = *(const u32x4*)(rp + bj * 128); wb[q][bj] = *(const u32x4*)(rp + DM + bj * 128); }
          }
          __builtin_amdgcn_sched_barrier(0);
#pragma unroll
          for (int q = 0; q < HGRP; ++q)
#pragma unroll
            for (int bj = 0; bj < 2; ++bj) {
              f32x4 g00, g01, g10, g11; unpack8f(wa[q][bj], g00, g01); unpack8f(wb[q][bj], g10, g11);
#pragma unroll
              for (int j = 0; j < 4; ++j) {
                acc[ai][bj][mh + q][0][j] *= g00[j] * __builtin_amdgcn_rcpf(fmaxf(g10[j], 1e-30f));
                acc[ai][bj][mh + q][1][j] *= g01[j] * __builtin_amdgcn_rcpf(fmaxf(g11[j], 1e-30f));
              }
            }
          __builtin_amdgcn_sched_barrier(0);
        }
    }
  }
};
struct EpiBrF {
  static constexpr bool TILE = true; static constexpr int GRP = 1;
  const u16* hb; u16* mb;
  DI void tile(f32x4 (&acc)[2][2][4][2], int brow, int bcol, int wr, int wc, int fr, int fq, LAS char* lds) const {
    int fr_ = fr; asm volatile("" : "+v"(fr_));
    const long r0 = brow + wr * 64 + fr_; const int c0 = bcol + wc * 32 + fq * 8;
    const u16* gp = hb + r0 * DIN + C_GL + 3 * DM + c0;
    u16* op = mb + r0 * DM + c0;
#pragma unroll
    for (int ai = 0; ai < 2; ++ai)
#pragma unroll
      for (int mh = 0; mh < 4; mh += HGRP) {
        u32x4 wg[HGRP][2];
#pragma unroll
        for (int q = 0; q < HGRP; ++q)
#pragma unroll
          for (int bj = 0; bj < 2; ++bj) wg[q][bj] = *(const u32x4*)(gp + (long)(ai * 128 + (mh + q) * 16) * DIN + bj * 128);
        __builtin_amdgcn_sched_barrier(0);
#pragma unroll
        for (int q = 0; q < HGRP; ++q)
#pragma unroll
          for (int bj = 0; bj < 2; ++bj) {
            f32x4 g0, g1; unpack8f(wg[q][bj], g0, g1);
            const f32x4 v0 = acc[ai][bj][mh + q][0] * g0, v1 = acc[ai][bj][mh + q][1] * g1;
            u32x4 w = {cvtpk(v0[0], v0[1]), cvtpk(v0[2], v0[3]), cvtpk(v1[0], v1[1]), cvtpk(v1[2], v1[3])};
            *(u32x4*)(op + (long)(ai * 128 + (mh + q) * 16) * DM + bj * 128) = w;
          }
        __builtin_amdgcn_sched_barrier(0);
      }
  }
};
struct EpiOutLN {
  static constexpr bool TILE = true; static constexpr int GRP = 1;
  float* X; u16* Xb; float* outp; const float* g; const float* b; float* stats; unsigned* cnt; float alpha; int last, pm, pn;
  DI void tile(f32x4 (&acc)[2][2][4][2], int brow, int bcol, int wr, int wc, int fr, int fq, LAS char* lds) const {
    LAS float* red = (LAS float*)lds;
    LAS float* rst = (LAS float*)(lds + 8192);
    { int fr_ = fr; asm volatile("" : "+v"(fr_));
      const float* xb = X + (long)(brow + wr * 64 + fr_) * DM + bcol + wc * 32 + fq * 8;
#pragma unroll
      for (int ai = 0; ai < 2; ++ai)
#pragma unroll
        for (int mh = 0; mh < 4; mh += 2) {
          f32x4 xr[2][2][2];
#pragma unroll
          for (int q = 0; q < 2; ++q)
#pragma unroll
            for (int bj = 0; bj < 2; ++bj) { const f32x4* xp = (const f32x4*)(xb + (long)(ai * 128 + (mh + q) * 16) * DM + bj * 128); xr[q][bj][0] = xp[0]; xr[q][bj][1] = xp[1]; }
          __builtin_amdgcn_sched_barrier(0);
#pragma unroll
          for (int q = 0; q < 2; ++q) {
            const int m = mh + q; const int rl = ai * 128 + wr * 64 + m * 16 + fr; float sm = 0.f, sq = 0.f;
#pragma unroll
            for (int bj = 0; bj < 2; ++bj) {
              const f32x4 y0 = alpha * xr[q][bj][0] + acc[ai][bj][m][0], y1 = alpha * xr[q][bj][1] + acc[ai][bj][m][1];
              acc[ai][bj][m][0] = y0; acc[ai][bj][m][1] = y1;
#pragma unroll
              for (int j = 0; j < 4; ++j) { sm += y0[j] + y1[j]; sq += y0[j] * y0[j] + y1[j] * y1[j]; }
            }
            sm += shx<16>(sm); sq += shx<16>(sq);
            { auto r0 = __builtin_amdgcn_permlane32_swap(__float_as_uint(sm), __float_as_uint(sm), false, false); sm = __uint_as_float(r0[0]) + __uint_as_float(r0[1]);
              auto r1 = __builtin_amdgcn_permlane32_swap(__float_as_uint(sq), __float_as_uint(sq), false, false); sq = __uint_as_float(r1[0]) + __uint_as_float(r1[1]); }
            if (fq == 0) { red[(rl * 4 + wc) * 2] = sm; red[(rl * 4 + wc) * 2 + 1] = sq; }
          }
          SCHED;
        }
    }
    __syncthreads();
    const int tid = otid();
    float* st = stats + ((long)(pm * 8) * 256) * 2;
    if (tid < 256) {
      float s4 = 0.f, q4 = 0.f;
#pragma unroll
      for (int w = 0; w < 4; ++w) { s4 += red[(tid * 4 + w) * 2]; q4 += red[(tid * 4 + w) * 2 + 1]; }
      __hip_atomic_store(st + ((long)pn * 256 + tid) * 2, s4, __ATOMIC_RELAXED, __HIP_MEMORY_SCOPE_AGENT);
      __hip_atomic_store(st + ((long)pn * 256 + tid) * 2 + 1, q4, __ATOMIC_RELAXED, __HIP_MEMORY_SCOPE_AGENT);
    }
    asm volatile("s_waitcnt vmcnt(0)" ::: "memory");
    __syncthreads();
    if (tid == 0) {
      unsigned* c = cnt + pm * 64;
      __builtin_amdgcn_fence(__ATOMIC_RELEASE, "agent");
      asm volatile("s_waitcnt vmcnt(0)" ::: "memory");
      (void)__hip_atomic_fetch_add(c, 1u, __ATOMIC_RELAXED, __HIP_MEMORY_SCOPE_AGENT);
      unsigned sp = 0;
      while (__hip_atomic_load(c, __ATOMIC_RELAXED, __HIP_MEMORY_SCOPE_AGENT) < 8u) { __builtin_amdgcn_s_sleep(1); if (++sp > (1u << 22)) break; }
      __builtin_amdgcn_fence(__ATOMIC_ACQUIRE, "agent");
      asm volatile("s_waitcnt vmcnt(0)" ::: "memory");
    }
    __syncthreads();
    if (tid < 256) {
      float s8 = 0.f, q8 = 0.f;
#pragma unroll
      for (int j = 0; j < 8; ++j) { s8 += __hip_atomic_load(st + ((long)j * 256 + tid) * 2, __ATOMIC_RELAXED, __HIP_MEMORY_SCOPE_AGENT); q8 += __hip_atomic_load(st + ((long)j * 256 + tid) * 2 + 1, __ATOMIC_RELAXED, __HIP_MEMORY_SCOPE_AGENT); }
      const float mu = s8 * (1.f / DM); const float var = fmaxf(q8 * (1.f / DM) - mu * mu, 0.f);
      rst[tid * 2] = mu; rst[tid * 2 + 1] = rsqrtf(var + 1e-5f);
    }
    __syncthreads();
#pragma unroll
    for (int ai = 0; ai < 2; ++ai)
#pragma unroll
      for (int m = 0; m < 4; ++m) {
        const int rl = ai * 128 + wr * 64 + m * 16 + fr; const float mu = rst[rl * 2], rs = rst[rl * 2 + 1];
#pragma unroll
        for (int bj = 0; bj < 2; ++bj) {
          const int col = bcol + bj * 128 + wc * 32 + fq * 8;
          const f32x4 g0 = *(const f32x4*)(g + col), g1 = *(const f32x4*)(g + col + 4), b0 = *(const f32x4*)(b + col), b1 = *(const f32x4*)(b + col + 4);
          f32x4 v0 = (acc[ai][bj][m][0] - mu) * rs * g0 + b0, v1 = (acc[ai][bj][m][1] - mu) * rs * g1 + b1;
          if (last) { f32x4* op = (f32x4*)(outp + (long)(brow + rl) * DM + col); op[0] = v0; op[1] = v1; }
          else {
            f32x4* xp = (f32x4*)(X + (long)(brow + rl) * DM + col); xp[0] = v0; xp[1] = v1;
            u32x4 w = {cvtpk(v0[0], v0[1]), cvtpk(v0[2], v0[3]), cvtpk(v1[0], v1[1]), cvtpk(v1[2], v1[3])};
            *(u32x4*)(Xb + (long)(brow + rl) * DM + col) = w;
          }
        }
        SCHED;
      }
  }
};

DI void phase_tables(const Params& p) {
  const int gt = blockIdx.x * NTHR + otid(), gn = gridDim.x * NTHR;
  for (int e = gt; e < S * 8; e += gn) { const int t = e >> 3, i = e & 7; float sn, cs; sincosf((float)t * powf(500000.f, -(float)i * (1.f / 8.f)), &sn, &cs); p.tA()[e] = cs; p.tA()[S * 8 + e] = sn; }
  for (int e = gt; e < S * 16; e += gn) { const int t = e >> 4, i = e & 15; float sn, cs; sincosf((float)t * powf(500000.f, -(float)i * (1.f / 16.f)), &sn, &cs); p.tD()[e] = cs; p.tD()[S * 16 + e] = sn; }
  for (int e = gt; e < 128 * 32; e += gn) { const int t = e >> 5, i = e & 31; float sn, cs; sincosf((float)t * powf(10000.f, -(float)i * (1.f / 32.f)), &sn, &cs); p.tC()[e] = cs; p.tC()[128 * 32 + e] = sn; }
}
DI void ld8f(const float* q, float (&v)[8]) { const f32x4 a = *(const f32x4*)q, b = *(const f32x4*)(q + 4); v[0] = a[0]; v[1] = a[1]; v[2] = a[2]; v[3] = a[3]; v[4] = b[0]; v[5] = b[1]; v[6] = b[2]; v[7] = b[3]; }
DI void phase_prep(const Params& p, int l) {
  const int tid = otid(), wid = tid >> 6, lane = tid & 63;
  const float* qg = p.qn_g + l * 128; const float* kg = p.kn_g + l * 128;
  for (int t = blockIdx.x * 8 + wid; t < S; t += gridDim.x * 8) {
    u16* hr = p.hb() + (long)t * DIN;
    {
      int base, off2; const float* ct; const float* st_;
      if (lane < 16) { base = (lane < 8) ? (C_AQ + lane * 64) : (C_AK + (lane - 8) * 64); off2 = 8; ct = p.tA() + t * 8; st_ = ct + S * 8; }
      else { const int k = lane - 16, v = k >> 1, hf = k & 1; base = ((v < 12) ? (C_DQ + v * 128) : (C_DK + (v - 12) * 128)) + hf * 8; off2 = 16; ct = p.tD() + t * 16 + hf * 8; st_ = ct + S * 16; }
      float x1[8], x2[8], cs[8], sn[8], o1[8], o2[8];
      unpack8(*(const u32x4*)(hr + base), x1); unpack8(*(const u32x4*)(hr + base + off2), x2); ld8f(ct, cs); ld8f(st_, sn);
#pragma unroll
      for (int i = 0; i < 8; ++i) { o1[i] = x1[i] * cs[i] - x2[i] * sn[i]; o2[i] = x2[i] * cs[i] + x1[i] * sn[i]; }
      *(u32x4*)(hr + base) = pack8(o1); *(u32x4*)(hr + base + off2) = pack8(o2);
    }
#pragma unroll
    for (int ps = 0; ps < 2; ++ps) {
      const int v = ps * 4 + (lane >> 4), c = lane & 15;
      if (v < 6) {
        const int base = ((v < 4) ? (C_CQ + v * 128) : (C_CK + (v - 4) * 128)) + c * 8;
        float x[8], g[8], cs[8], sn[8], pr[8], o[8];
        unpack8(*(const u32x4*)(hr + base), x);
        float ss = 0.f;
#pragma unroll
        for (int i = 0; i < 8; ++i) ss += x[i] * x[i];
        ss = sum16(ss);
        const float rs = rsqrtf(ss * (1.f / 128.f) + 1e-6f);
        ld8f(((v < 4) ? qg : kg) + c * 8, g);
        const float* ct = p.tC() + ((c < 8) ? (t >> 6) : (t & 63)) * 32 + (c & 3) * 8;
        ld8f(ct, cs); ld8f(ct + 128 * 32, sn);
#pragma unroll
        for (int i = 0; i < 8; ++i) { x[i] *= rs * g[i]; pr[i] = shx<4>(x[i]); }
        const float sg = (c & 4) ? 1.f : -1.f;
#pragma unroll
        for (int i = 0; i < 8; ++i) o[i] = x[i] * cs[i] + sg * pr[i] * sn[i];
        *(u32x4*)(hr + base) = pack8(o);
      }
    }
  }
}

constexpr float THR = 8.f;
DI int crow(int r, int hi) { return (r & 3) + 8 * (r >> 2) + 4 * hi; }
struct MaskArgs { int u0, u1, u2; int v0, v1; LAS const float* tbl; };
template <int MODE>
DI void mask_apply(f32x16& p0, f32x16& p1, int j, const MaskArgs& ma) {
  if constexpr (MODE == 1) {
    const int rp = ma.u0 + j; const bool rv = (rp >= ma.u1) && (rp < ma.u1 + 8);
    if (rv) {
      LAS const float* tp = ma.tbl + ((rp - ma.u2 + 7) * 31 + ma.v0);
      const int cb = ma.v1;
#pragma unroll
      for (int r = 0; r < 16; ++r) {
        const int cc = (r & 3) + 8 * (r >> 2);
        p0[r] = ((unsigned)(cc + cb) < 16u) ? (p0[r] + tp[cc]) : -2e30f;
        p1[r] = ((unsigned)(cc + 32 + cb) < 16u) ? (p1[r] + tp[cc + 32]) : -2e30f;
      }
    } else {
#pragma unroll
      for (int r = 0; r < 16; ++r) { p0[r] = -2e30f; p1[r] = -2e30f; }
    }
  } else if constexpr (MODE == 2) {
    const int base = ma.v0 + j * 64;
#pragma unroll
    for (int r = 0; r < 16; ++r) {
      const int cc = (r & 3) + 8 * (r >> 2);
      p0[r] = ((unsigned)(base + cc) <= 128u) ? p0[r] : -2e30f;
      p1[r] = ((unsigned)(base + cc + 32) <= 128u) ? p1[r] : -2e30f;
    }
  }
}

template <int DQK>
DI void partialSM(f32x16& p0, f32x16& p1, float& m_reg, float& mn, float& alpha) {
  constexpr float SCALE = (DQK == 64) ? 0.125f : 0.088388347648318440f;
  constexpr float C = SCALE * 1.4426950408889634f;
  float pmax = p0[0];
#pragma unroll
  for (int r = 1; r < 16; ++r) pmax = fmaxf(pmax, p0[r]);
#pragma unroll
  for (int r = 0; r < 16; ++r) pmax = fmaxf(pmax, p1[r]);
  { auto rr = __builtin_amdgcn_permlane32_swap(__float_as_uint(pmax), __float_as_uint(pmax), false, false);
    pmax = fmaxf(__uint_as_float(rr[0]), __uint_as_float(rr[1])); }
  if (__builtin_expect(__all(pmax - m_reg <= THR / SCALE), 1)) { mn = m_reg; alpha = 1.f; }
  else { mn = fmaxf(m_reg, pmax); alpha = __builtin_amdgcn_exp2f((m_reg - mn) * C); m_reg = mn; }
  const float mnC = -mn * C;
#pragma unroll
  for (int r = 0; r < 16; ++r) p0[r] = fmaf(p0[r], C, mnC);
#pragma unroll
  for (int r = 0; r < 16; ++r) p1[r] = fmaf(p1[r], C, mnC);
#pragma unroll
  for (int r = 0; r < 16; ++r) p0[r] = __builtin_amdgcn_exp2f(p0[r]);
}
DI void finishSM(f32x16& p0, f32x16& p1, float alpha, float& l_reg, bf16x8& pa0, bf16x8& pa1, bf16x8& pa2, bf16x8& pa3) {
#pragma unroll
  for (int r = 0; r < 16; ++r) p1[r] = __builtin_amdgcn_exp2f(p1[r]);
  float ps = 0;
#pragma unroll
  for (int r = 0; r < 16; ++r) ps += p0[r];
#pragma unroll
  for (int r = 0; r < 16; ++r) ps += p1[r];
  { auto rr = __builtin_amdgcn_permlane32_swap(__float_as_uint(ps), __float_as_uint(ps), false, false);
    ps = __uint_as_float(rr[0]) + __uint_as_float(rr[1]); }
  l_reg = l_reg * alpha + ps;
#define PK4(P, BASE, OUT) do { unsigned a0 = cvtpk(P[BASE + 0], P[BASE + 1]), a1 = cvtpk(P[BASE + 2], P[BASE + 3]);   \
    unsigned b0 = cvtpk(P[BASE + 4], P[BASE + 5]), b1 = cvtpk(P[BASE + 6], P[BASE + 7]);                              \
    auto r0 = __builtin_amdgcn_permlane32_swap(a0, b0, false, false); auto r1 = __builtin_amdgcn_permlane32_swap(a1, b1, false, false); \
    u32x4 w = {r0[0], r1[0], r0[1], r1[1]}; OUT = __builtin_bit_cast(bf16x8, w); } while (0)
  PK4(p0, 0, pa0); PK4(p0, 8, pa1); PK4(p1, 0, pa2); PK4(p1, 8, pa3);
#undef PK4
}
template <int DQK>
DI void qkt(f32x16& p0, f32x16& p1, LAS const char* Ks, const bf16x8* qr, int r32, int hi) {
  p0 = f32x16{}; p1 = f32x16{};
#pragma unroll
  for (int d0 = 0; d0 < DQK / 16; ++d0) {
    const int cb = (d0 * 16 + hi * 8) * 2;
    const bf16x8 b0 = *(LAS const bf16x8*)(Ks + r32 * (DQK * 2) + (cb ^ ((r32 & 7) << 4)));
    const bf16x8 b1 = *(LAS const bf16x8*)(Ks + (32 + r32) * (DQK * 2) + (cb ^ ((r32 & 7) << 4)));
    p0 = __builtin_amdgcn_mfma_f32_32x32x16_bf16(b0, qr[d0], p0, 0, 0, 0);
    p1 = __builtin_amdgcn_mfma_f32_32x32x16_bf16(b1, qr[d0], p1, 0, 0, 0);
  }
}
DI int v_st(int k, int c) { const int kk = (k & ~0xC) | ((k & 4) << 1) | ((k & 8) >> 1); return ((kk >> 3) * 4 + (c >> 5)) * 512 + ((kk & 7) * 32 + (c & 31)) * 2; }
DI int v_rd_base(int lane) { return ((lane & 3) << 3) | (((lane >> 2) & 3) << 6) | (((lane >> 4) & 1) << 5) | (((lane >> 5) & 1) << 8); }
constexpr int v_rd_off(int d0, int ks, int half) { return d0 * 512 + ks * 4096 + half * 2048; }
template <int OFF> DI s16x4 tr_read(int vb) {
  s16x4 r; asm volatile("ds_read_b64_tr_b16 %0, %1 offset:%2" : "=&v"(r) : "v"(vb), "i"(OFF) : "memory"); return r;
}
#define SBAR() __builtin_amdgcn_sched_barrier(0)
template <int D0> DI void pv_one(f32x16& od, int vb, bf16x8 pa0, bf16x8 pa1, bf16x8 pa2, bf16x8 pa3) {
  const s16x4 l0 = tr_read<v_rd_off(D0, 0, 0)>(vb), h0 = tr_read<v_rd_off(D0, 0, 1)>(vb), l1 = tr_read<v_rd_off(D0, 1, 0)>(vb), h1 = tr_read<v_rd_off(D0, 1, 1)>(vb);
  const s16x4 l2 = tr_read<v_rd_off(D0, 2, 0)>(vb), h2 = tr_read<v_rd_off(D0, 2, 1)>(vb), l3 = tr_read<v_rd_off(D0, 3, 0)>(vb), h3 = tr_read<v_rd_off(D0, 3, 1)>(vb);
  asm volatile("s_waitcnt lgkmcnt(0)" ::: "memory"); SBAR();
#define PK(L, H) (bf16x8){L[0], L[1], L[2], L[3], H[0], H[1], H[2], H[3]}
  od = __builtin_amdgcn_mfma_f32_32x32x16_bf16(pa0, PK(l0, h0), od, 0, 0, 0);
  od = __builtin_amdgcn_mfma_f32_32x32x16_bf16(pa1, PK(l1, h1), od, 0, 0, 0);
  od = __builtin_amdgcn_mfma_f32_32x32x16_bf16(pa2, PK(l2, h2), od, 0, 0, 0);
  od = __builtin_amdgcn_mfma_f32_32x32x16_bf16(pa3, PK(l3, h3), od, 0, 0, 0);
#undef PK
}
DI void pv_d0(f32x16* o, int vb, bf16x8 pa0, bf16x8 pa1, bf16x8 pa2, bf16x8 pa3) {
  pv_one<0>(o[0], vb, pa0, pa1, pa2, pa3); pv_one<1>(o[1], vb, pa0, pa1, pa2, pa3); pv_one<2>(o[2], vb, pa0, pa1, pa2, pa3); pv_one<3>(o[3], vb, pa0, pa1, pa2, pa3);
}

template <int DQK, int MODE>
DI void attn_body(const u16* __restrict__ Qb, long ldq, const u16* __restrict__ Kh, const u16* __restrict__ Vh, long ldk, int NT,
                  LAS char* lds, const MaskArgs& ma, f32x16 (&o)[4], float& lse_out) {
  constexpr float SCALE = (DQK == 64) ? 0.125f : 0.088388347648318440f;
  constexpr int SHM_V = 16384, SHM_K = 64 * DQK * 2, ND = DQK / 16;
  const int tid = otid(), wid = tid >> 6, lane = tid & 63, r32 = lane & 31, hi = lane >> 5;
  LAS char* V_lds = lds; LAS char* K_lds = lds + 2 * SHM_V;
  LAS float* ws = (LAS float*)(lds + 65536) + wid * 64; LAS float* li_l = ws; LAS float* al_l = ws + 32;
  float m_reg = -1e30f, l_reg = 0;
#pragma unroll
  for (int d = 0; d < 4; ++d) o[d] = f32x16{};
  bf16x8 qr[ND];
  const u16* Qw = Qb + (long)(wid * 32 + r32) * ldq + hi * 8;
#pragma unroll
  for (int d0 = 0; d0 < ND; ++d0) qr[d0] = *(const bf16x8*)(Qw + d0 * 16);
  const int sr = tid >> 4, sc = (tid & 15) * 8, vst0 = v_st(sr, sc), vst1 = v_st(32 + sr, sc);
  const int ksr = (DQK == 128) ? (tid >> 4) : (tid >> 3), ksc = (DQK == 128) ? ((tid & 15) * 8) : ((tid & 7) * 8);
  const int kst0 = ksr * (DQK * 2) + ((ksc * 2) ^ ((ksr & 7) << 4)), kst1 = (32 + ksr) * (DQK * 2) + ((ksc * 2) ^ ((ksr & 7) << 4));
  const int vb0 = (int)(uintptr_t)V_lds + v_rd_base(lane);
  bf16x8 vsA0, vsA1, ksA0, ksA1, vsB0, vsB1, ksB0, ksB1;
#define SLOAD(X, k0) do { vs##X##0 = *(const bf16x8*)(Vh + (long)((k0) + sr) * ldk + sc); vs##X##1 = *(const bf16x8*)(Vh + (long)((k0) + 32 + sr) * ldk + sc); \
    ks##X##0 = *(const bf16x8*)(Kh + (long)((k0) + ksr) * ldk + ksc); if constexpr (DQK == 128) ks##X##1 = *(const bf16x8*)(Kh + (long)((k0) + 32 + ksr) * ldk + ksc); } while (0)
#define SWRITE(b, X) do { *(LAS bf16x8*)(V_lds + (b) * SHM_V + vst0) = vs##X##0; *(LAS bf16x8*)(V_lds + (b) * SHM_V + vst1) = vs##X##1; \
    *(LAS bf16x8*)(K_lds + (b) * SHM_K + kst0) = ks##X##0; if constexpr (DQK == 128) *(LAS bf16x8*)(K_lds + (b) * SHM_K + kst1) = ks##X##1; } while (0)
#define SWAIT() do { if constexpr (DQK == 128) asm volatile("s_waitcnt vmcnt(4)" ::: "memory"); else asm volatile("s_waitcnt vmcnt(3)" ::: "memory"); } while (0)
#define RESC(a) do { if (__any((a) < 1.f)) { if (hi == 0) al_l[r32] = (a); asm volatile("s_waitcnt lgkmcnt(0)" ::: "memory"); \
    _Pragma("unroll") for (int d = 0; d < 4; ++d) _Pragma("unroll") for (int r = 0; r < 16; ++r) o[d][r] *= al_l[crow(r, hi)]; } } while (0)
  f32x16 pA0, pA1, pB0, pB1; float mnA, mnB, alA, alB; bf16x8 pa0, pa1, pa2, pa3;
  SLOAD(A, 0); asm volatile("s_waitcnt vmcnt(0)" ::: "memory"); SWRITE(0, A); __syncthreads();
  qkt<DQK>(pA0, pA1, K_lds, qr, r32, hi); mask_apply<MODE>(pA0, pA1, 0, ma); partialSM<DQK>(pA0, pA1, m_reg, mnA, alA);
  SLOAD(B, 64); if (2 < NT) SLOAD(A, 128);
  SWAIT(); SWRITE(1, B); __syncthreads();
  for (int j = 1; j + 1 < NT; j += 2) {
    SBAR(); qkt<DQK>(pB0, pB1, K_lds + SHM_K, qr, r32, hi);
    finishSM(pA0, pA1, alA, l_reg, pa0, pa1, pa2, pa3); SBAR();
    SLOAD(B, (j + 2) * 64); SBAR();
    pv_d0(o, vb0, pa0, pa1, pa2, pa3); mask_apply<MODE>(pB0, pB1, j, ma); partialSM<DQK>(pB0, pB1, m_reg, mnB, alB);
    __syncthreads(); SWAIT(); SWRITE(0, A);
    RESC(alB); __syncthreads();
    SBAR(); qkt<DQK>(pA0, pA1, K_lds, qr, r32, hi);
    finishSM(pB0, pB1, alB, l_reg, pa0, pa1, pa2, pa3); SBAR();
    if (j + 3 < NT) SLOAD(A, (j + 3) * 64); SBAR();
    pv_d0(o, vb0 + SHM_V, pa0, pa1, pa2, pa3); mask_apply<MODE>(pA0, pA1, j + 1, ma); partialSM<DQK>(pA0, pA1, m_reg, mnA, alA);
    __syncthreads(); SWAIT(); SWRITE(1, B);
    RESC(alA); __syncthreads();
  }
  SBAR(); qkt<DQK>(pB0, pB1, K_lds + SHM_K, qr, r32, hi);
  finishSM(pA0, pA1, alA, l_reg, pa0, pa1, pa2, pa3); SBAR();
  pv_d0(o, vb0, pa0, pa1, pa2, pa3); mask_apply<MODE>(pB0, pB1, NT - 1, ma); partialSM<DQK>(pB0, pB1, m_reg, mnB, alB);
  __syncthreads(); RESC(alB);
  finishSM(pB0, pB1, alB, l_reg, pa0, pa1, pa2, pa3); SBAR();
  pv_d0(o, vb0 + SHM_V, pa0, pa1, pa2, pa3);
  if (hi == 0) li_l[r32] = l_reg; asm volatile("s_waitcnt lgkmcnt(0)" ::: "memory");
#pragma unroll
  for (int r = 0; r < 16; ++r) { const float rl = __builtin_amdgcn_rcpf(li_l[crow(r, hi)]);
#pragma unroll
    for (int d = 0; d < 4; ++d) o[d][r] *= rl; }
  lse_out = m_reg * SCALE + __logf(l_reg);
  __syncthreads();
#undef SLOAD
#undef SWRITE
#undef SWAIT
#undef RESC
}

DI void stage_o(LAS char* lds, const f32x16 (&o)[4], int wid, int r32, int hi) {
  LAS float* R = (LAS float*)(lds + wid * 16384) + (4 * hi) * 128 + r32;
#pragma unroll
  for (int d = 0; d < 4; ++d)
#pragma unroll
    for (int r = 0; r < 16; ++r) R[((r & 3) + 8 * (r >> 2)) * 128 + d * 32] = o[d][r];
}
DI void read_o(LAS char* lds, int wid, int row, int c8, float (&v)[8]) {
  LAS const float* R = (LAS const float*)(lds + wid * 16384) + row * 128 + c8;
  const f32x4 a = *(LAS const f32x4*)R, b = *(LAS const f32x4*)(R + 4);
  v[0] = a[0]; v[1] = a[1]; v[2] = a[2]; v[3] = a[3]; v[4] = b[0]; v[5] = b[1]; v[6] = b[2]; v[7] = b[3];
}

DI void epi_gated(const Params& p, LAS char* lds, const f32x16 (&o)[4], long q0, int zcol, int ycol) {
  const int tid = otid(), wid = tid >> 6, lane = tid & 63, r32 = lane & 31, hi = lane >> 5;
  stage_o(lds, o, wid, r32, hi);
  const int c8 = (lane & 15) * 8;
  u32x4 zr[8];
#pragma unroll
  for (int ps = 0; ps < 8; ++ps) zr[ps] = *(const u32x4*)(p.hb() + (q0 + wid * 32 + ps * 4 + (lane >> 4)) * DIN + zcol + c8);
  __builtin_amdgcn_sched_barrier(0);
#pragma unroll
  for (int ps = 0; ps < 8; ++ps) {
    const int row = ps * 4 + (lane >> 4); const long t = q0 + wid * 32 + row;
    float v[8], z[8]; read_o(lds, wid, row, c8, v);
    unpack8(zr[ps], z);
#pragma unroll
    for (int i = 0; i < 8; ++i) v[i] *= z[i];
    *(u32x4*)(p.ys() + t * DM + ycol + c8) = pack8(v);
  }
  __syncthreads();
}

DI void item_A(const Params& p, int l, int h, int qb, LAS char* lds) {
  const long q0 = (long)qb * 256;
  {
    MaskArgs ma{}; f32x16 o[4]; float lse;
    attn_body<64, 0>(p.hb() + q0 * DIN + C_AQ + h * 128, DIN, p.hb() + C_AK + h * 128, p.hb() + C_AV + h * 128, DIN, S / 64, lds, ma, o, lse);
    const int tid = otid(), wid = tid >> 6, lane = tid & 63, r32 = lane & 31, hi = lane >> 5, c8 = (lane & 15) * 8;
    float* st = p.stash() + ((long)blockIdx.x * 256 + wid * 32) * 128 + c8;
    stage_o(lds, o, wid, r32, hi);
#pragma unroll 2
    for (int ps = 0; ps < 8; ++ps) {
      const int row = ps * 4 + (lane >> 4);
      LAS const float* R = (LAS const float*)(lds + wid * 16384) + row * 128 + c8;
      *(f32x4*)(st + row * 128) = *(LAS const f32x4*)R; *(f32x4*)(st + row * 128 + 4) = *(LAS const f32x4*)(R + 4);
    }
    __syncthreads();
  }
  {
    MaskArgs ma{}; f32x16 o[4]; float lse;
    attn_body<64, 0>(p.hb() + q0 * DIN + C_AQ + h * 128 + 64, DIN, p.hb() + C_AK + h * 128 + 64, p.hb() + C_AV + h * 128, DIN, S / 64, lds, ma, o, lse);
    const int tid = otid(), wid = tid >> 6, lane = tid & 63, r32 = lane & 31, hi = lane >> 5;
    stage_o(lds, o, wid, r32, hi);
  }
  const int tid = otid(), wid = tid >> 6, lane = tid & 63, c8 = (lane & 15) * 8;
  const float* lp = p.lam + l * 256;
  float e1 = lp[lane] * lp[64 + lane], e2 = lp[128 + lane] * lp[192 + lane];
  e1 = wave_sum(e1); e2 = wave_sum(e2);
  int lo = l; asm volatile("" : "+s"(lo));
  float c08 = 0.8f; asm volatile("" : "+v"(c08));
  const float lam_init = c08 - 0.6f * expf(-0.3f * (float)lo);
  const float lam = expf(e1) - expf(e2) + lam_init;
  const float* st = p.stash() + ((long)blockIdx.x * 256 + wid * 32) * 128 + c8;
  const float* sg = p.subln_g + l * 128 + c8;
  const f32x4 g0 = *(const f32x4*)sg, g1 = *(const f32x4*)(sg + 4);
  const float gs[8] = {g0[0], g0[1], g0[2], g0[3], g1[0], g1[1], g1[2], g1[3]};
#pragma unroll
  for (int hf = 0; hf < 2; ++hf) {
    u32x4 zr[4]; f32x4 sa[4][2];
#pragma unroll
    for (int q = 0; q < 4; ++q) {
      const int row = (hf * 4 + q) * 4 + (lane >> 4);
      zr[q] = *(const u32x4*)(p.hb() + (q0 + wid * 32 + row) * DIN + C_AZ + h * 128 + c8);
      sa[q][0] = *(const f32x4*)(st + row * 128); sa[q][1] = *(const f32x4*)(st + row * 128 + 4);
    }
    __builtin_amdgcn_sched_barrier(0);
#pragma unroll
    for (int q = 0; q < 4; ++q) {
      const int row = (hf * 4 + q) * 4 + (lane >> 4); const long t = q0 + wid * 32 + row;
      float v[8], z[8]; read_o(lds, wid, row, c8, v);
      const f32x4 a0 = sa[q][0], a1 = sa[q][1];
      const float o1[8] = {a0[0], a0[1], a0[2], a0[3], a1[0], a1[1], a1[2], a1[3]};
      float ss = 0.f;
#pragma unroll
      for (int i = 0; i < 8; ++i) { v[i] = o1[i] - lam * v[i]; ss += v[i] * v[i]; }
      ss = sum16(ss);
      const float sc = rsqrtf(ss * (1.f / 128.f) + 1e-6f) * (1.f - lam_init);
      unpack8(zr[q], z);
#pragma unroll
      for (int i = 0; i < 8; ++i) v[i] = v[i] * sc * gs[i] * z[i];
      *(u32x4*)(p.ys() + t * DM + h * 128 + c8) = pack8(v);
    }
    __builtin_amdgcn_sched_barrier(0);
  }
  __syncthreads();
}
DI void item_C(const Params& p, int qh, int qb, LAS char* lds) {
  MaskArgs ma{}; f32x16 o[4]; float lse;
  const long q0 = (long)qb * 256; const int kv = qh >> 1;
  attn_body<128, 0>(p.hb() + q0 * DIN + C_CQ + qh * 128, DIN, p.hb() + C_CK + kv * 128, p.hb() + C_CV + kv * 128, DIN, S / 64, lds, ma, o, lse);
  epi_gated(p, lds, o, q0, C_CZ + qh * 128, 1024 + qh * 128);
}
DI void item_B(const Params& p, int l, int h, int g, LAS char* lds) {
  const int tid = otid(), wid = tid >> 6, lane = tid & 63, r32 = lane & 31, hi = lane >> 5;
  LAS float* tbl = (LAS float*)(lds + 65536 + 2048);
  const float* rp = p.rpb + ((long)l * 4 + h) * 465;
  for (int i = tid; i < 561; i += NTHR) { const int k = i - 48; tbl[i] = (k >= 0 && k < 465) ? rp[k] * 11.313708498984761f : 0.f; }
  __syncthreads();
  int rb = 4 * g - 4; rb = rb < 0 ? 0 : (rb > 116 ? 116 : rb);
  const int rq = __builtin_amdgcn_readfirstlane(4 * g + (wid >> 1)), cq = (wid & 1) * 32 + r32;
  int r0 = rq - 4; r0 = r0 < 0 ? 0 : (r0 > 120 ? 120 : r0);
  int c0 = cq - 8; c0 = c0 < 0 ? 0 : (c0 > 48 ? 48 : c0);
  MaskArgs ma{}; ma.u0 = rb; ma.u1 = r0; ma.u2 = rq; ma.v0 = 63 - cq + 4 * hi; ma.v1 = 4 * hi - c0; ma.tbl = tbl;
  f32x16 o[4]; float lse;
  const long q0 = (long)g * 256;
  attn_body<128, 1>(p.hb() + q0 * DIN + C_BQ + h * 128, DIN, p.hb() + (long)rb * 64 * DIN + C_BK + h * 128, p.hb() + (long)rb * 64 * DIN + C_BV + h * 128, DIN, 12, lds, ma, o, lse);
  epi_gated(p, lds, o, q0, C_BZ + h * 128, 512 + h * 128);
}
DI void item_D(const Params& p, int idx, LAS char* lds) {
  const int tid = otid(), wid = tid >> 6, lane = tid & 63, r32 = lane & 31, hi = lane >> 5;
  const int grp = idx >> 7, rem = idx & 127, hd = rem >> 5, vb = rem & 31;
  const int rate = (grp == 0) ? 1 : (grp == 1 ? 4 : 16);
  const int L = S / rate, bpc = L / 256;
  const int rho = vb / bpc, qbi = vb % bpc, q0 = qbi * 256;
  int kb = q0 - 64; kb = kb < 0 ? 0 : (kb > L - 384 ? L - 384 : kb);
  MaskArgs ma{}; ma.v0 = kb - (q0 + wid * 32 + r32) + 4 * hi + 64;
  f32x16 o[4]; float lse;
  const int head = grp * 4 + hd;
  const long ld = (long)rate * DIN;
  attn_body<128, 2>(p.hb() + (long)(rho + rate * q0) * DIN + C_DQ + head * 128, ld, p.hb() + (long)(rho + rate * kb) * DIN + C_DK + head * 128,
                    p.hb() + (long)(rho + rate * kb) * DIN + C_DV + head * 128, ld, 6, lds, ma, o, lse);
  if (hi == 0) { const long t = rho + (long)rate * (q0 + wid * 32 + r32); p.lse()[((long)grp * S + t) * 4 + hd] = lse; }
  stage_o(lds, o, wid, r32, hi);
  u16* odg = p.od() + (long)grp * S * 512 + hd * 128;
  const int c8 = (lane & 15) * 8;
#pragma unroll 2
  for (int ps = 0; ps < 8; ++ps) {
    const int row = ps * 4 + (lane >> 4); const long t = rho + (long)rate * (q0 + wid * 32 + row);
    float v[8]; read_o(lds, wid, row, c8, v);
    *(u32x4*)(odg + t * 512 + c8) = pack8(v);
  }
  __syncthreads();
}

DI void phase_attn(const Params& p, int l, LAS char* lds) {
  for (int item = blockIdx.x; item < 256; item += gridDim.x) {
    const int xcd = item & 7, slot = item >> 3;
    if (slot < 16) {
      item_A(p, l, xcd >> 1, (xcd & 1) * 16 + slot, lds);
    } else {
      const int s2 = slot - 16, cidx = s2 * 8 + xcd;
      item_C(p, xcd >> 1, (xcd & 1) * 16 + s2, lds);
      item_B(p, l, cidx >> 5, cidx & 31, lds);
      if (cidx < 64) item_D(p, cidx * 3, lds);
      else { for (int k = 0; k < 3; ++k) item_D(p, cidx * 3 + k, lds); for (int k = 1; k < 3; ++k) item_D(p, (cidx - 64) * 3 + k, lds); }
      if (cidx < 64) {
        EpiH e; e.hb = p.hb(); e.bg = p.b_gate + (long)l * 4 * DM; e.kind = 2;
        gemm_tile(p.Xb(), DM, p.WinT() + (long)l * DIN * DM, DM, DM, (cidx >> 1) * 256, (72 + (cidx & 1)) * 256, e, NoHook(), lds);
      }
    }
  }
}

DI void phase_dmerge(const Params& p) {
  for (int task = blockIdx.x * NTHR + otid(); task < S * 64; task += gridDim.x * NTHR) {
    const int t = task >> 6, ch = task & 63, hd = ch >> 4, col = ch * 8;
    const float l0 = p.lse()[((long)0 * S + t) * 4 + hd], l1 = p.lse()[((long)1 * S + t) * 4 + hd], l2 = p.lse()[((long)2 * S + t) * 4 + hd];
    const float mx = fmaxf(l0, fmaxf(l1, l2));
    float w0 = __expf(l0 - mx), w1 = __expf(l1 - mx), w2 = __expf(l2 - mx);
    const float inv = 1.f / (w0 + w1 + w2); w0 *= inv; w1 *= inv; w2 *= inv;
    const u32x4 a = *(const u32x4*)(p.od() + ((long)0 * S + t) * 512 + col);
    const u32x4 b = *(const u32x4*)(p.od() + ((long)1 * S + t) * 512 + col);
    const u32x4 c = *(const u32x4*)(p.od() + ((long)2 * S + t) * 512 + col);
    const u32x4 z = *(const u32x4*)(p.hb() + (long)t * DIN + C_DZ + col);
    u32x4 r;
#pragma unroll
    for (int i = 0; i < 4; ++i) {
      const float lo = (w0 * bflo(a[i]) + w1 * bflo(b[i]) + w2 * bflo(c[i])) * bflo(z[i]);
      const float hh = (w0 * bfhi(a[i]) + w1 * bfhi(b[i]) + w2 * bfhi(c[i])) * bfhi(z[i]);
      r[i] = cvtpk(lo, hh);
    }
    *(u32x4*)(p.ys() + (long)t * DM + 1536 + col) = r;
  }
}


#ifndef SELFCHECK
#define SELFCHECK 0
#endif
#if SELFCHECK
constexpr int CHK_L = 1;
constexpr size_t WS_FLAG = WS_END + 1024;
template <class KT, class BI>
DI void naive_attn(const u16* hb, const u16* q, int dqk, int nkeys, KT ktok, int kcol, int vcol, BI bias, float scale, LAS float* L, int tid) {
  LAS float* sc = L; LAS float* qv = L + 8192; LAS float* red = L + 8192 + 128; LAS float* ov = red + 512;
  __syncthreads();
  if (tid < dqk) qv[tid] = bf2f(q[tid]);
  __syncthreads();
  float mx = -3e38f;
  for (int j = tid; j < nkeys; j += 512) {
    const int tk = ktok(j); float s = -3e38f;
    if (tk >= 0) { const u16* kp = hb + (long)tk * DIN + kcol; float a = 0; for (int d = 0; d < dqk; ++d) a += qv[d] * bf2f(kp[d]); s = a * scale + bias(j); }
    sc[j] = s; mx = fmaxf(mx, s);
  }
  red[tid] = mx; __syncthreads();
  for (int st = 256; st >= 1; st >>= 1) { if (tid < st) red[tid] = fmaxf(red[tid], red[tid + st]); __syncthreads(); }
  mx = red[0]; __syncthreads();
  float sm = 0;
  for (int j = tid; j < nkeys; j += 512) { const float e = (sc[j] > -1e38f) ? expf(sc[j] - mx) : 0.f; sc[j] = e; sm += e; }
  red[tid] = sm; __syncthreads();
  for (int st = 256; st >= 1; st >>= 1) { if (tid < st) red[tid] += red[tid + st]; __syncthreads(); }
  sm = red[0]; __syncthreads();
  const int col = tid & 127, part = tid >> 7; float acc = 0;
  for (int j = part; j < nkeys; j += 4) { const int tk = ktok(j); if (tk >= 0) acc += sc[j] * bf2f(hb[(long)tk * DIN + vcol + col]); }
  red[tid] = acc; __syncthreads();
  if (tid < 128) ov[tid] = (red[tid] + red[tid + 128] + red[tid + 256] + red[tid + 384]) / sm;
  if (tid == 0) ov[128] = mx + logf(sm);
  __syncthreads();
}
DI void chk_compare(const Params& p, LAS float* L, const float* ref128  , float refv, int t, int ycol, int bit, int tid) {
  LAS float* red = L + 8192 + 128;
  __syncthreads();
  red[tid] = (tid < 128) ? refv * refv : 0.f; __syncthreads();
  for (int st = 256; st >= 1; st >>= 1) { if (tid < st) red[tid] += red[tid + st]; __syncthreads(); }
  const float rms = sqrtf(red[0] * (1.f / 128.f)); __syncthreads();
  if (tid < 128) {
    const float got = bf2f(p.ys()[(long)t * DM + ycol + tid]);
    const float err = fabsf(got - refv);
    if (!(err <= 0.03f * (fabsf(refv) + rms) + 1e-6f)) atomicOr((unsigned*)(p.ws + WS_FLAG), (unsigned)bit);
  }
  __syncthreads();
}
DI void selfcheck(const Params& p, int l, LAS char* lds) {
  const int tid = threadIdx.x; LAS float* L = (LAS float*)lds; LAS float* ov = L + 8192 + 128 + 512; LAS float* keep = ov + 160;
  const u16* hb = p.hb();
  const int b = blockIdx.x, br = b & 3, hd = (b >> 2) & 3, si = b >> 4;
  for (int rep = 0; rep < 2; ++rep) {
    const int t = rep == 0 ? ((si * 523 + 17 * br + 131 * hd) & 8191) : ((si < 8) ? si * 9 : 8191 - (si - 8) * 9);
    if (br == 0) {
      const float* lp = p.lam + l * 256; float e1 = 0, e2 = 0; for (int i = 0; i < 64; ++i) { e1 += lp[i] * lp[64 + i]; e2 += lp[128 + i] * lp[192 + i]; }
      const float lam_init = 0.8f - 0.6f * expf(-0.3f * (float)l), lam = expf(e1) - expf(e2) + lam_init;
      naive_attn(hb, hb + (long)t * DIN + C_AQ + hd * 128, 64, S, [](int j) { return j; }, C_AK + hd * 128, C_AV + hd * 128, [](int) { return 0.f; }, 0.125f, L, tid);
      const float o1 = (tid < 128) ? ov[tid] : 0.f;
      naive_attn(hb, hb + (long)t * DIN + C_AQ + hd * 128 + 64, 64, S, [](int j) { return j; }, C_AK + hd * 128 + 64, C_AV + hd * 128, [](int) { return 0.f; }, 0.125f, L, tid);
      const float o = (tid < 128) ? (o1 - lam * ov[tid]) : 0.f;
      LAS float* red = L + 8192 + 128;
      __syncthreads(); red[tid] = o * o; __syncthreads();
      for (int st = 256; st >= 1; st >>= 1) { if (tid < st) red[tid] += red[tid + st]; __syncthreads(); }
      const float ms = red[0] * (1.f / 128.f); __syncthreads();
      float refv = 0.f;
      if (tid < 128) refv = o * rsqrtf(ms + 1e-6f) * p.subln_g[l * 128 + tid] * (1.f - lam_init) * bf2f(hb[(long)t * DIN + C_AZ + hd * 128 + tid]);
      chk_compare(p, L, nullptr, refv, t, hd * 128, 1, tid);
    } else if (br == 1) {
      const int r = t >> 6, c = t & 63; int r0 = r - 4; r0 = r0 < 0 ? 0 : (r0 > 120 ? 120 : r0); int c0 = c - 8; c0 = c0 < 0 ? 0 : (c0 > 48 ? 48 : c0);
      const float* rp = p.rpb + ((long)l * 4 + hd) * 465;
      naive_attn(hb, hb + (long)t * DIN + C_BQ + hd * 128, 128, 128, [=](int j) { return (r0 + (j >> 4)) * 64 + c0 + (j & 15); }, C_BK + hd * 128, C_BV + hd * 128,
                 [=](int j) { return rp[(r0 + (j >> 4) - r + 7) * 31 + (c0 + (j & 15) - c + 15)]; }, 0.088388347648318440f, L, tid);
      float refv = 0.f; if (tid < 128) refv = ov[tid] * bf2f(hb[(long)t * DIN + C_BZ + hd * 128 + tid]);
      chk_compare(p, L, nullptr, refv, t, 512 + hd * 128, 2, tid);
    } else if (br == 2) {
      const int kv = hd >> 1;
      naive_attn(hb, hb + (long)t * DIN + C_CQ + hd * 128, 128, S, [](int j) { return j; }, C_CK + kv * 128, C_CV + kv * 128, [](int) { return 0.f; }, 0.088388347648318440f, L, tid);
      float refv = 0.f; if (tid < 128) refv = ov[tid] * bf2f(hb[(long)t * DIN + C_CZ + hd * 128 + tid]);
      chk_compare(p, L, nullptr, refv, t, 1024 + hd * 128, 4, tid);
    } else {
      float og[3], lg[3];
#pragma unroll
      for (int g = 0; g < 3; ++g) {
        const int rate = g == 0 ? 1 : (g == 1 ? 4 : 16), head = g * 4 + hd;
        naive_attn(hb, hb + (long)t * DIN + C_DQ + head * 128, 128, 129, [=](int j) { const int idx = t + rate * (j - 64); return (idx >= 0 && idx < S) ? idx : -1; },
                   C_DK + head * 128, C_DV + head * 128, [](int) { return 0.f; }, 0.088388347648318440f, L, tid);
        og[g] = (tid < 128) ? ov[tid] : 0.f; lg[g] = ov[128];
      }
      const float mx = fmaxf(lg[0], fmaxf(lg[1], lg[2])); float w0 = expf(lg[0] - mx), w1 = expf(lg[1] - mx), w2 = expf(lg[2] - mx); const float inv = 1.f / (w0 + w1 + w2);
      float refv = 0.f; if (tid < 128) refv = (w0 * og[0] + w1 * og[1] + w2 * og[2]) * inv * bf2f(hb[(long)t * DIN + C_DZ + hd * 128 + tid]);
      chk_compare(p, L, nullptr, refv, t, 1536 + hd * 128, 8, tid);
    }
  }
}
#endif

#define XB_TMO      128
#define XB_XCNT(j)  (256  + 64 * (j))
#define XB_XSUB(j)  (1280 + 64 * (j))
#define XB_XGEN(j)  (2304 + 64 * (j))
#define XB_TOP      3328
#define XB_TOPGEN   3392
#define XCD_BAR_WORDS 3456
#define XB_SPIN_CAP (1u << 18)
DI unsigned xb_ld(unsigned* p)              { return __hip_atomic_load(p, __ATOMIC_RELAXED, __HIP_MEMORY_SCOPE_AGENT); }
DI unsigned xb_add(unsigned* p, unsigned v) { return __hip_atomic_fetch_add(p, v, __ATOMIC_RELAXED, __HIP_MEMORY_SCOPE_AGENT); }
DI unsigned xb_xcc_id() { return (unsigned)__builtin_amdgcn_s_getreg((3 << 11) | 20) & 0xFu; }
#define XB_SPIN(cond, bar) do { unsigned _sp = 0; while (cond) { __builtin_amdgcn_s_sleep(1); \
    if ((++_sp & 255u) == 0u) { if (xb_ld(&(bar)[XB_TMO])) break; if (_sp > XB_SPIN_CAP) { atomicAdd(&(bar)[XB_TMO], 1u); break; } } } } while (0)
struct XcdBarrier { unsigned* bar; unsigned x; volatile LAS unsigned* st; };
DI XcdBarrier xcd_barrier_post(unsigned* bar, volatile LAS unsigned* st) {
  XcdBarrier b; b.bar = bar; b.x = xb_xcc_id(); b.st = st;
  if (otid() == 0) (void)xb_add(&bar[XB_XCNT(b.x)], 1u);
  return b;
}
DI void xcd_barrier_complete(unsigned* bar, unsigned x, unsigned& nloc, unsigned& nx) {
  const unsigned G = gridDim.x * gridDim.y * gridDim.z;
  unsigned sum, cnt, mine, sp = 0u;
  for (;;) {
    sum = 0u; cnt = 0u; mine = 0u;
#pragma unroll
    for (unsigned j = 0; j < 16; ++j) { const unsigned c = xb_ld(&bar[XB_XCNT(j)]); sum += c; cnt += (c > 0u) ? 1u : 0u; mine = (j == x) ? c : mine; }
    if (sum == G) break;
    __builtin_amdgcn_s_sleep(1);
    if ((++sp & 255u) == 0u) { if (xb_ld(&bar[XB_TMO])) break; if (sp > XB_SPIN_CAP) { atomicAdd(&bar[XB_TMO], 1u); break; } }
  }
  nloc = mine > 0u ? mine : 1u; nx = cnt > 0u ? cnt : 1u;
}
DI void xcd_barrier(const XcdBarrier& b) {
  asm volatile("s_waitcnt vmcnt(0)" ::: "memory");
  __syncthreads();
  if (otid() == 0) {
    unsigned* bar = b.bar;
    __builtin_amdgcn_s_waitcnt(0);
    unsigned nloc = b.st[0], nx = b.st[1];
    if (nloc == 0u) { xcd_barrier_complete(bar, b.x, nloc, nx); b.st[0] = nloc; b.st[1] = nx; }
    const unsigned old = xb_add(&bar[XB_XSUB(b.x)], 1u);
    const unsigned gen = old / nloc;
    if (old + 1u == (gen + 1u) * nloc) {
      __builtin_amdgcn_fence(__ATOMIC_RELEASE, "agent");
      asm volatile("s_waitcnt vmcnt(0)" ::: "memory");
      const unsigned og = xb_add(&bar[XB_TOP], 1u);
      const unsigned tg = og / nx;
      if (og + 1u == (tg + 1u) * nx) xb_add(&bar[XB_TOPGEN], 1u);
      else XB_SPIN(xb_ld(&bar[XB_TOPGEN]) == tg, bar);
      __builtin_amdgcn_fence(__ATOMIC_ACQUIRE, "agent");
      xb_add(&bar[XB_XGEN(b.x)], 1u);
      asm volatile("s_waitcnt vmcnt(0)" ::: "memory");
    } else {
      XB_SPIN(xb_ld(&bar[XB_XGEN(b.x)]) == gen, bar);
      __builtin_amdgcn_fence(__ATOMIC_ACQUIRE, "agent");
      asm volatile("s_waitcnt vmcnt(0)" ::: "memory");
    }
  }
  __syncthreads();
}
#ifndef REP_P0
#define REP_P0 1
#endif
#ifndef REP_G1
#define REP_G1 1
#endif
#ifndef REP_AT
#define REP_AT 1
#endif
#ifndef REP_BR
#define REP_BR 1
#endif
#ifndef REP_SM
#define REP_SM 1
#endif
__global__ void __launch_bounds__(NTHR) mega_fwd(Params p0) {
  LAS char* lds = (LAS char*)shm_;
  cg::grid_group grid = cg::this_grid();
  if ((threadIdx.x & 63) == 0) ((volatile LAS int*)(lds + 131072 + 16))[hw_slot()] = threadIdx.x >> 6;
  volatile LAS unsigned* xst = (volatile LAS unsigned*)(lds + 131072);
  if (threadIdx.x == 0) { xst[0] = 0u; xst[1] = 0u; }
  __syncthreads();
  const XcdBarrier xb = xcd_barrier_post((unsigned*)(p0.ws + WS_BAR), xst);
  for (int ph = p0.ph_lo; ph < p0.ph_hi; ++ph) {
    typedef const __attribute__((address_space(4))) Params* CParamsP;
    CParamsP pk = (CParamsP)__builtin_amdgcn_kernarg_segment_ptr();
    asm volatile("" : "+s"(pk));
    Params p;
    p.x = pk->x; p.emb_g = pk->emb_g; p.emb_b = pk->emb_b; p.w_in = pk->w_in; p.b_gate = pk->b_gate; p.lam = pk->lam; p.subln_g = pk->subln_g;
    p.rpb = pk->rpb; p.qn_g = pk->qn_g; p.kn_g = pk->kn_g; p.w_branch = pk->w_branch; p.w_out = pk->w_out; p.ln_g = pk->ln_g; p.ln_b = pk->ln_b;
    p.out = pk->out; p.ws = pk->ws; p.ph_lo = 0; p.ph_hi = 0;
    if (ph == 0) {
      for (int rep = 0; rep < REP_P0; ++rep) {
      phase_transpose(p.w_in, p.WinT(), DM, DIN, NL, lds);
      phase_transpose(p.w_branch, p.WbT(), DM, DM, NL, lds);
      phase_transpose(p.w_out, p.WoT(), DM, DM, NL, lds);
      }
      phase_ln(p.x, p.emb_g, p.emb_b, p.X(), p.Xb());
      phase_tables(p);
    } else {
      const int l = (ph - 1) / 6, sp = (ph - 1) % 6;
      if (sp == 0) {
        const int nM = S / 256, nN = DIN / 256 - 2;
        for (int rep = 0; rep < REP_G1; ++rep) {
          bool pre = false;
          for (int L = blockIdx.x; L < nM * nN; L += gridDim.x) {
            int pm, pn; tile_order(L, nM, nN, pm, pn);
            int pm2 = -1, pn2 = 0; if (L + (int)gridDim.x < nM * nN) tile_order(L + gridDim.x, nM, nN, pm2, pn2);
            EpiH e; e.hb = p.hb(); e.bg = p.b_gate + (long)l * 4 * DM;
            e.kind = (pn >= 42) ? 2 : ((pn == 6 || pn == 7 || pn == 14 || pn == 15 || pn == 20 || pn == 21 || pn == 40 || pn == 41) ? 1 : 0);
            gemm_tile(p.Xb(), DM, p.WinT() + (long)l * DIN * DM, DM, DM, pm * 256, pn * 256, e, NoHook(), lds, pre, pm2 < 0 ? -1 : pm2 * 256, pn2 * 256);
            pre = pm2 >= 0;
          }
        }
      } else if (sp == 1) {
        phase_prep(p, l);
      } else if (sp == 2) {
        for (int rep = 0; rep < REP_AT; ++rep) phase_attn(p, l, lds);
      } else if (sp == 3) {
        for (int rep = 0; rep < REP_SM; ++rep) phase_dmerge(p);
      } else if (sp == 4) {
        const int nM = S / 256, nN = DM / 256;
        for (int rep = 0; rep < REP_BR; ++rep)
        for (int L = blockIdx.x; L < nM * nN; L += gridDim.x) {
          int pm, pn; tile_order(L, nM, nN, pm, pn);
          EpiBrF e; e.hb = p.hb(); e.mb = p.mb(); GateHook gh; gh.hb = p.hb();
          gemm_tile(p.ys(), DM, p.WbT() + (long)l * DM * DM, DM, DM, pm * 256, pn * 256, e, gh, lds);
        }
      } else if (sp == 5) {
        const int nM = S / 256, nN = DM / 256;
        for (int L = blockIdx.x; L < nM * nN; L += gridDim.x) {
          int pm, pn; tile_order(L, nM, nN, pm, pn);
          EpiOutLN e; e.X = p.X(); e.Xb = p.Xb(); e.outp = p.out; e.g = p.ln_g + l * DM; e.b = p.ln_b + l * DM; e.alpha = 1.6817928305074290f;
          e.stats = (float*)(p.ws + WS_LNS) + (long)l * 32 * 8 * 256 * 2; e.cnt = (unsigned*)(p.ws + WS_LNC) + l * 32 * 64; e.last = (l == NL - 1); e.pm = pm; e.pn = pn;
          gemm_tile(p.mb(), DM, p.WoT() + (long)l * DM * DM, DM, DM, pm * 256, pn * 256, e, NoHook(), lds);
        }
      }
    }
    if (ph + 1 < p0.ph_hi) { if (p0.ph_lo < 0) grid.sync(); else xcd_barrier(xb); }
  }
}

#if SELFCHECK
__global__ void __launch_bounds__(NTHR) chk_kernel(Params p) {
  extern __shared__ __attribute__((aligned(16))) char shm2_[];
  selfcheck(p, CHK_L, (LAS char*)shm2_);
}

#ifndef CHK2_SIGN
#define CHK2_SIGN 1.f
#endif
__global__ void __launch_bounds__(NTHR) chk2_kernel(Params p) {
  extern __shared__ __attribute__((aligned(16))) char shm3_[];
  float* hraw = (float*)shm3_;
  const int tid = threadIdx.x, b = blockIdx.x, l = CHK_L;
  int t = (b < 224) ? ((b * 37 + 11) & 8191) : ((b - 224 < 16) ? (b - 224) * 5 : 8191 - (b - 240) * 5);
  const u16* xr = p.Xb() + (long)t * DM;
  for (int i = tid; i < 4864; i += NTHR) {
    const int col = i < 1024 ? i : (i < 1792 ? 4096 + (i - 1024) : 5632 + (i - 1792));
    const u16* wr = p.WinT() + ((long)l * DIN + col) * DM; float a = 0.f;
    for (int k = 0; k < DM; ++k) a += bf2f(xr[k]) * bf2f(wr[k]);
    hraw[i] = a;
  }
  __syncthreads();
  const float ft = (float)t;
  for (int i = tid; i < 4864; i += NTHR) {
    float ref; unsigned bit; int col;
    if (i < 1024) {
      const int d = i & 63, base = i & ~63; bit = 16u; col = i;
      if (d < 16) { const int dd = d & 7; const float ang = ft * powf(500000.f, -(float)dd / 8.f), cs = cosf(ang), sn = CHK2_SIGN * sinf(ang), x1 = hraw[base + dd], x2 = hraw[base + dd + 8];
        ref = d < 8 ? x1 * cs - x2 * sn : x2 * cs + x1 * sn; } else ref = hraw[i];
    } else if (i < 1792) {
      const int j = i - 1024, vec = j >> 7, d = j & 127, base = 1024 + (j & ~127); bit = 32u; col = 4096 + j;
      float ss = 0.f; for (int e = 0; e < 128; ++e) ss += hraw[base + e] * hraw[base + e];
      const float rs = rsqrtf(ss / 128.f + 1e-6f); const float* g = (vec < 4 ? p.qn_g : p.kn_g) + l * 128;
      const int seg = d >> 6, dd = d & 31, hi32 = (d >> 5) & 1; const float pos = seg ? (float)(t & 63) : (float)(t >> 6);
      const float ang = pos * powf(10000.f, -(float)dd / 32.f), cs = cosf(ang), sn = CHK2_SIGN * sinf(ang);
      const float x1 = hraw[base + seg * 64 + dd] * rs * g[seg * 64 + dd], x2 = hraw[base + seg * 64 + dd + 32] * rs * g[seg * 64 + dd + 32];
      ref = hi32 ? x2 * cs + x1 * sn : x1 * cs - x2 * sn;
    } else {
      const int j = i - 1792, d = j & 127, base = 1792 + (j & ~127); bit = 64u; col = 5632 + j;
      if (d < 32) { const int dd = d & 15; const float ang = ft * powf(500000.f, -(float)dd / 16.f), cs = cosf(ang), sn = CHK2_SIGN * sinf(ang), x1 = hraw[base + dd], x2 = hraw[base + dd + 16];
        ref = d < 16 ? x1 * cs - x2 * sn : x2 * cs + x1 * sn; } else ref = hraw[i];
    }
    const float got = bf2f(p.hb()[(long)t * DIN + col]);
    if (!(fabsf(got - ref) <= 0.02f * fabsf(ref) + 0.03f)) atomicOr((unsigned*)(p.ws + WS_FLAG), bit);
  }
}
__global__ void poison_kernel(Params p) {
  const unsigned f = *(unsigned*)(p.ws + WS_FLAG);
  if (f) p.out[0] = 1000.f * (float)f;
}
#endif
#ifndef MK_MULTI
#define MK_MULTI 0
#endif
extern "C" void kernel_launch(void* const* d_in, const int* in_sizes, int n_in, void* d_out, int out_size, void* d_ws, size_t ws_size, hipStream_t stream) {
  static int grid = 0;
  if (grid == 0) {
    if (n_in != 14 || in_sizes[0] != S * DM || out_size != S * DM || ws_size < WS_END + 4096) {
      fprintf(stderr, "kernel_launch: shape/workspace mismatch (n_in %d, in0 %d, out %d, ws %zu, need %zu)\n", n_in, n_in > 0 ? in_sizes[0] : -1, out_size, ws_size, (size_t)WS_END);
      grid = -1; return; }
    int dev = 0, cus = 0, per_cu = 0;
    hipGetDevice(&dev);
    hipDeviceGetAttribute(&cus, hipDeviceAttributeMultiprocessorCount, dev);
    if (hipFuncSetAttribute((const void*)mega_fwd, hipFuncAttributeMaxDynamicSharedMemorySize, LDS_BYTES) != hipSuccess) { fprintf(stderr, "kernel_launch: hipFuncSetAttribute failed\n"); grid = -1; return; }
    if (hipOccupancyMaxActiveBlocksPerMultiprocessor(&per_cu, (const void*)mega_fwd, NTHR, LDS_BYTES) != hipSuccess || per_cu < 1) { fprintf(stderr, "kernel_launch: occupancy query failed (%d)\n", per_cu); per_cu = 1; }
    (void)hipGetLastError();
    grid = cus * 1;
    fprintf(stderr, "kernel_launch: cus %d per_cu %d grid %d\n", cus, per_cu, grid);
  }
  if (grid < 0) return;
  Params p{};
  p.x = (const float*)d_in[0]; p.emb_g = (const float*)d_in[1]; p.emb_b = (const float*)d_in[2]; p.w_in = (const float*)d_in[3]; p.b_gate = (const float*)d_in[4];
  p.lam = (const float*)d_in[5]; p.subln_g = (const float*)d_in[6]; p.rpb = (const float*)d_in[7]; p.qn_g = (const float*)d_in[8]; p.kn_g = (const float*)d_in[9];
  p.w_branch = (const float*)d_in[10]; p.w_out = (const float*)d_in[11]; p.ln_g = (const float*)d_in[12]; p.ln_b = (const float*)d_in[13];
  p.out = (float*)d_out;
  p.ws = (char*)d_ws;
  const int NPH = 1 + 6 * NL;
#if MK_MULTI
  for (int ph = 0; ph < NPH; ++ph) {
    p.ph_lo = ph; p.ph_hi = ph + 1;
    hipLaunchKernelGGL(mega_fwd, dim3(grid), dim3(NTHR), LDS_BYTES, stream, p);
  }
#else
  (void)hipMemsetAsync(p.ws + WS_BAR, 0, 16384 + NL * 32 * 256, stream);
#if SELFCHECK
  hipMemsetAsync(p.ws + WS_FLAG, 0, 256, stream);
  { p.ph_lo = 0; p.ph_hi = 1 + 6 * CHK_L + 2; void* args[] = {&p};
    hipError_t e = hipLaunchCooperativeKernel((const void*)mega_fwd, dim3(grid), dim3(NTHR), args, LDS_BYTES, stream);
    if (e != hipSuccess) fprintf(stderr, "kernel_launch: cooperative launch failed: %s (grid %d)\n", hipGetErrorString(e), grid); }
  hipLaunchKernelGGL(chk2_kernel, dim3(256), dim3(NTHR), 32768, stream, p);
  (void)hipMemsetAsync(p.ws + WS_BAR, 0, 16384, stream);
  { p.ph_lo = 1 + 6 * CHK_L + 2; p.ph_hi = 1 + 6 * CHK_L + 4; void* args[] = {&p};
    hipError_t e = hipLaunchCooperativeKernel((const void*)mega_fwd, dim3(grid), dim3(NTHR), args, LDS_BYTES, stream);
    if (e != hipSuccess) fprintf(stderr, "kernel_launch: cooperative launch failed: %s (grid %d)\n", hipGetErrorString(e), grid); }
  hipFuncSetAttribute((const void*)chk_kernel, hipFuncAttributeMaxDynamicSharedMemorySize, 65536);
  hipLaunchKernelGGL(chk_kernel, dim3(256), dim3(NTHR), 65536, stream, p);
  (void)hipMemsetAsync(p.ws + WS_BAR, 0, 16384, stream);
  { p.ph_lo = 1 + 6 * CHK_L + 4; p.ph_hi = NPH; void* args[] = {&p};
    hipError_t e = hipLaunchCooperativeKernel((const void*)mega_fwd, dim3(grid), dim3(NTHR), args, LDS_BYTES, stream);
    if (e != hipSuccess) fprintf(stderr, "kernel_launch: cooperative launch failed: %s (grid %d)\n", hipGetErrorString(e), grid); }
  hipLaunchKernelGGL(poison_kernel, dim3(1), dim3(1), 0, stream, p);
#else
  p.ph_lo = 0; p.ph_hi = NPH;
  void* args[] = {&p};
  hipError_t e = hipLaunchCooperativeKernel((const void*)mega_fwd, dim3(grid), dim3(NTHR), args, LDS_BYTES, stream);
  if (e != hipSuccess) fprintf(stderr, "kernel_launch: cooperative launch failed: %s (grid %d)\n", hipGetErrorString(e), grid);
#endif
#endif
}
```
